# Optimizing an MI355X kernel written in HIP

```python
import jax, jax.numpy as jnp
from jax import lax
import numpy as np

D_MODEL = 1024
BATCH = 16
SEQ = 2048
DEPTH = 2

GRID_W = 64
CTX_LEN = 256
HEAD_DIM = 64
A_WIDTH = 512
A_HEADS = A_WIDTH // HEAD_DIM
B_WIDTH = 512
B_HEADS = B_WIDTH // HEAD_DIM
DECAY_LORA = 64
ICLR_LORA = 64
GATE_LORA = 128
GN_EPS = 64e-5
NA_ROWS = 8
NA_COLS = 16
CONV_WIDTH = 31
N_EXPERTS = 32
TOP_K = 4
D_EXPERT = D_MODEL
SWIGLU_ALPHA = 1.702
SWIGLU_LIMIT = 7.0
EXPERT_BLOCK = 256
RMS_EPS = 1e-6
LN_EPS = 1e-5
N_EVEN = (DEPTH + 1) // 2
N_ODD = DEPTH // 2

COL_QB = 0
COL_RA = COL_QB + B_WIDTH
COL_GD = COL_RA + A_WIDTH
COL_KA = COL_GD + GATE_LORA
COL_VA = COL_KA + A_WIDTH
COL_WD = COL_VA + A_WIDTH
COL_AD = COL_WD + 2 * DECAY_LORA
COL_KB = COL_AD + 2 * ICLR_LORA
COL_VB = COL_KB + B_WIDTH
COL_END = COL_VB + B_WIDTH
SHIFT_COLS = COL_KB - COL_RA

kernel_name = 'hybrid_rwkv7_natten_conformer_moe_dit'


def _rmsnorm(x, g):
    xf = x.astype(jnp.float32)
    y = xf * lax.rsqrt(jnp.mean(xf * xf, axis=-1, keepdims=True) + RMS_EPS)
    return y.astype(x.dtype) * g


def _layernorm(x, g, b):
    xf = x.astype(jnp.float32)
    mu = jnp.mean(xf, axis=-1, keepdims=True)
    var = jnp.mean(jnp.square(xf - mu), axis=-1, keepdims=True)
    return ((xf - mu) * lax.rsqrt(var + LN_EPS)).astype(x.dtype) * g + b


def _adaln(x, g, shift, scale):
    return _rmsnorm(x, g) * (1 + scale) + shift


def _token_shift(p, mu_prev, mu_next):
    prev = jnp.pad(p, ((0, 0), (1, 0), (0, 0)))[:, :-1]
    nxt = jnp.pad(p, ((0, 0), (0, 1), (0, 0)))[:, 1:]
    return p + mu_prev * (prev - p) + mu_next * (nxt - p)


def _to_scan(x):
    B, T, _, C = x.shape
    x = jnp.stack([x[:, :, 0], jnp.flip(x[:, :, 1], axis=1)], axis=0)
    return x.reshape(2, B, T, C // HEAD_DIM, HEAD_DIM).transpose(2, 0, 1, 3, 4).astype(jnp.float32)


def _rwkv7_terms(s, w0, w2, a0, a2, k_k, k_a):
    B, T, _ = s.shape
    k = s[..., :A_WIDTH]
    v = s[..., A_WIDTH:2 * A_WIDTH]
    wd = s[..., 2 * A_WIDTH:2 * A_WIDTH + 2 * DECAY_LORA].reshape(B, T, 2, DECAY_LORA)
    ad = s[..., 2 * A_WIDTH + 2 * DECAY_LORA:].reshape(B, T, 2, ICLR_LORA)
    w_log = -jax.nn.softplus(-(w0 + jnp.einsum('btdr,drc->btdc', jnp.tanh(wd), w2))) - 0.5
    decay = jnp.exp(-jnp.exp(w_log.astype(jnp.float32)))
    a = jax.nn.sigmoid(a0 + jnp.einsum('btdr,drc->btdc', ad, a2))
    kk = (k * k_k).reshape(B, T, A_HEADS, HEAD_DIM).astype(jnp.float32)
    kk = (kk / jnp.maximum(jnp.sqrt(jnp.sum(kk * kk, axis=-1, keepdims=True)), 1e-12)).reshape(B, T, A_WIDTH)
    k_dir = k[:, :, None] * (1 + (a - 1) * k_a)
    both = lambda t: jnp.broadcast_to(t[:, :, None], (B, T, 2, A_WIDTH))
    scan_in = (_to_scan(decay), _to_scan(k_dir), _to_scan(both(v)),
               _to_scan(both(-kk)), _to_scan(kk[:, :, None] * a))
    return scan_in, k_dir, v


def _wkv7_update(S, w, k, v, aa, bb):
    sa = jnp.einsum('dbhij,dbhj->dbhi', S, aa)
    return S * w[..., None, :] + sa[..., :, None] * bb[..., None, :] + v[..., :, None] * k[..., None, :]


def _neighbourhood_attention(q, k, v, kc, vc, rpb):
    B, T, _ = q.shape
    rows = T // GRID_W
    kh = min(NA_ROWS, rows)
    H = B_HEADS
    grid = lambda t: t.reshape(B, rows, GRID_W, H, HEAD_DIM)
    qg = grid(q) * (HEAD_DIM ** -0.5)
    kg = grid(k)
    vg = grid(v)
    kc = kc.reshape(B, -1, H, HEAD_DIM)
    vc = vc.reshape(B, -1, H, HEAD_DIM)
    col = jnp.arange(GRID_W)
    c_start = jnp.clip(col - NA_COLS // 2, 0, GRID_W - NA_COLS)
    col_ok = (col[None, :] >= c_start[:, None]) & (col[None, :] < c_start[:, None] + NA_COLS)
    dc = jnp.clip(col[None, :] - col[:, None], 1 - NA_COLS, NA_COLS - 1) + NA_COLS - 1
    n_loc = kh * GRID_W

    def row_block(r):
        r_start = jnp.clip(r - kh // 2, 0, rows - kh)
        k_rows = lax.dynamic_slice_in_dim(kg, r_start, kh, axis=1)
        v_rows = lax.dynamic_slice_in_dim(vg, r_start, kh, axis=1)
        q_r = lax.dynamic_index_in_dim(qg, r, axis=1, keepdims=False)
        dr = r_start + jnp.arange(kh) - r + NA_ROWS - 1
        bias = rpb[:, dr[None, :, None], dc[:, None, :]]
        s_loc = jnp.einsum('bchn,bkwhn->bhckw', q_r, k_rows).astype(jnp.float32) + bias
        s_loc = jnp.where(col_ok[:, None, :], s_loc, -jnp.inf)
        s_ctx = jnp.einsum('bchn,blhn->bhcl', q_r, kc).astype(jnp.float32)
        p = jax.nn.softmax(jnp.concatenate([s_loc.reshape(B, H, GRID_W, n_loc), s_ctx], axis=-1), axis=-1).astype(v.dtype)
        o = jnp.einsum('bhckw,bkwhn->bchn', p[..., :n_loc].reshape(B, H, GRID_W, kh, GRID_W), v_rows)
        return o + jnp.einsum('bhcl,blhn->bchn', p[..., n_loc:], vc)

    o = lax.map(row_block, jnp.arange(rows))
    return o.transpose(1, 0, 2, 3, 4).reshape(B, T, B_WIDTH)


def _even_mixer(h, hc, w_in, mu_prev, mu_next, w0, w2, a0, a2, g2, k_k, k_a, r_k, lnx_g, lnx_b, rpb, w_out):
    B, T, _ = h.shape
    p = h @ w_in
    pc = hc @ w_in[:, COL_KA:]
    s = _token_shift(p[..., COL_RA:COL_KB], mu_prev, mu_next)
    sc = _token_shift(pc[..., :COL_KB - COL_KA], mu_prev[COL_KA - COL_RA:], mu_next[COL_KA - COL_RA:])
    r = s[..., :A_WIDTH]
    g = jax.nn.sigmoid(s[..., A_WIDTH:A_WIDTH + GATE_LORA]) @ g2
    scan_in, k_dir, v = _rwkv7_terms(s[..., COL_KA - COL_RA:], w0, w2, a0, a2, k_k, k_a)
    scan_c, _, _ = _rwkv7_terms(sc, w0, w2, a0, a2, k_k, k_a)
    S0 = jnp.zeros((2, B, A_HEADS, HEAD_DIM, HEAD_DIM), jnp.float32)
    S_ctx, _ = lax.scan(lambda S, t: (_wkv7_update(S, *t), None), S0, scan_c)

    def step(S, t):
        S = _wkv7_update(S, *t[1:])
        return S, jnp.einsum('dbhij,dbhj->dbhi', S, t[0])

    r_scan = _to_scan(jnp.broadcast_to(r[:, :, None], (B, T, 2, A_WIDTH)))
    _, y = lax.scan(step, S_ctx, (r_scan,) + scan_in)
    y = (y[:, 0] + jnp.flip(y[:, 1], axis=0)).transpose(1, 0, 2, 3)
    mu = jnp.mean(y, axis=-1, keepdims=True)
    var = jnp.mean(jnp.square(y - mu), axis=-1, keepdims=True)
    y = ((y - mu) * lax.rsqrt(var + GN_EPS)).reshape(B, T, A_WIDTH).astype(h.dtype) * lnx_g + lnx_b
    rk = jnp.sum(r.reshape(B, T, 1, A_HEADS, HEAD_DIM) * k_dir.reshape(B, T, 2, A_HEADS, HEAD_DIM) * r_k, axis=(2, 4))
    bonus = (rk[..., None] * v.reshape(B, T, A_HEADS, HEAD_DIM)).reshape(B, T, A_WIDTH)
    o_a = (y + bonus) * g
    o_b = _neighbourhood_attention(p[..., COL_QB:COL_RA], p[..., COL_KB:COL_VB], p[..., COL_VB:],
                                   pc[..., COL_KB - COL_KA:COL_VB - COL_KA], pc[..., COL_VB - COL_KA:], rpb)
    return jnp.concatenate([o_a, o_b], axis=-1) @ w_out


def _conformer_conv(h, pw1_w, pw1_b, dw_w, dw_b, ln_g, ln_b, pw2_w, pw2_b):
    u = h @ pw1_w + pw1_b
    d = u.shape[-1] // 2
    u = u[..., :d] * jax.nn.sigmoid(u[..., d:])
    u = lax.conv_general_dilated(u, dw_w[:, None, :], (1,), [(CONV_WIDTH // 2, CONV_WIDTH // 2)],
                                 dimension_numbers=('NWC', 'WIO', 'NWC'), feature_group_count=d) + dw_b
    u = jax.nn.silu(_layernorm(u, ln_g, ln_b))
    return u @ pw2_w + pw2_b


def _moe(h, w_r, b_r, w1, b1, w2, b2):
    B, T, D = h.shape
    xt = h.reshape(-1, D)
    n = xt.shape[0]
    m = n * TOP_K
    logits = (xt @ w_r + b_r).astype(jnp.float32)
    top_v, top_i = lax.top_k(logits, TOP_K)
    gate = jax.nn.softmax(top_v, axis=-1).astype(h.dtype)
    flat_e = top_i.reshape(-1)
    order = jnp.argsort(flat_e)
    sorted_e = flat_e[order]
    counts = jnp.zeros((N_EXPERTS,), jnp.int32).at[flat_e].add(1)
    padded = (counts + EXPERT_BLOCK - 1) // EXPERT_BLOCK * EXPERT_BLOCK
    pad_end = jnp.cumsum(padded)
    pad_start = pad_end - padded
    start = jnp.cumsum(counts) - counts
    dest = pad_start[sorted_e] + jnp.arange(m) - start[sorted_e]
    n_blocks = -(-(m + N_EXPERTS * (EXPERT_BLOCK - 1)) // EXPERT_BLOCK)
    buf_tok = jnp.full((n_blocks * EXPERT_BLOCK,), n, jnp.int32).at[dest].set((order // TOP_K).astype(jnp.int32))
    buf_w = jnp.zeros((n_blocks * EXPERT_BLOCK,), h.dtype).at[dest].set(gate.reshape(-1)[order])
    block_e = jnp.minimum(jnp.searchsorted(pad_end, jnp.arange(n_blocks) * EXPERT_BLOCK, side='right'), N_EXPERTS - 1)
    x_pad = jnp.concatenate([xt, jnp.zeros((1, D), xt.dtype)], axis=0)

    def block(args):
        tok, e = args
        u = x_pad[tok] @ w1[e] + b1[e]
        glu = jnp.minimum(u[:, ::2], SWIGLU_LIMIT)
        lin = jnp.clip(u[:, 1::2], -SWIGLU_LIMIT, SWIGLU_LIMIT)
        act = glu * jax.nn.sigmoid(SWIGLU_ALPHA * glu) * (lin + 1)
        return act @ w2[e] + b2[e]

    y = lax.map(block, (buf_tok.reshape(n_blocks, EXPERT_BLOCK), block_e)).reshape(-1, D)
    out = jnp.zeros((n + 1, D), h.dtype).at[buf_tok].add(y * buf_w[:, None])[:n]
    return out.reshape(B, T, D)


def setup_inputs(seed: int = 0) -> dict:
    key = jax.random.key(seed)
    ks = iter(jax.random.split(key, 64))
    D = D_MODEL
    nrm = lambda shape, s: s * jax.random.normal(next(ks), shape, jnp.float32)
    uni = lambda shape, lo, hi: jax.random.uniform(next(ks), shape, jnp.float32, lo, hi)
    return {
        'x': nrm((BATCH, SEQ, D), 1.0),
        'c': nrm((BATCH, D), 1.0),
        'ctx': nrm((BATCH, CTX_LEN, D), 1.0),
        'c_ctx': nrm((D,), 1.0),
        'ada_w': nrm((DEPTH, D, 6 * D), 0.02),
        'ada_b': nrm((DEPTH, 6 * D), 0.02),
        'norm_mix_g': 1 + nrm((DEPTH, D), 0.02),
        'norm_ffn_g': 1 + nrm((DEPTH, D), 0.02),
        'final_norm_g': 1 + nrm((D,), 0.02),
        'mix_w_in': nrm((N_EVEN, D, COL_END), D ** -0.5),
        'shift_mu_prev': uni((N_EVEN, SHIFT_COLS), 0.0, 0.5),
        'shift_mu_next': uni((N_EVEN, SHIFT_COLS), 0.0, 0.5),
        'decay_w0': uni((N_EVEN, 2, A_WIDTH), -2.0, 1.0),
        'decay_w2': nrm((N_EVEN, 2, DECAY_LORA, A_WIDTH), 0.1 * DECAY_LORA ** -0.5),
        'iclr_a0': nrm((N_EVEN, 2, A_WIDTH), 0.1),
        'iclr_a2': nrm((N_EVEN, 2, ICLR_LORA, A_WIDTH), ICLR_LORA ** -0.5),
        'gate_g2': nrm((N_EVEN, GATE_LORA, A_WIDTH), GATE_LORA ** -0.5),
        'key_k': 0.85 + nrm((N_EVEN, A_WIDTH), 0.02),
        'key_a': 1 + nrm((N_EVEN, A_WIDTH), 0.02),
        'bonus_r_k': nrm((N_EVEN, A_HEADS, HEAD_DIM), 0.1),
        'lnx_g': 1 + nrm((N_EVEN, A_WIDTH), 0.02),
        'lnx_b': nrm((N_EVEN, A_WIDTH), 0.01),
        'na_rpb': nrm((N_EVEN, B_HEADS, 2 * NA_ROWS - 1, 2 * NA_COLS - 1), 0.02),
        'mix_w_out': nrm((N_EVEN, A_WIDTH + B_WIDTH, D), (A_WIDTH + B_WIDTH) ** -0.5),
        'conv_pw1_w': nrm((N_ODD, D, 2 * D), D ** -0.5),
        'conv_pw1_b': nrm((N_ODD, 2 * D), 0.01),
        'conv_dw_w': nrm((N_ODD, CONV_WIDTH, D), CONV_WIDTH ** -0.5),
        'conv_dw_b': nrm((N_ODD, D), 0.01),
        'conv_ln_g': 1 + nrm((N_ODD, D), 0.02),
        'conv_ln_b': nrm((N_ODD, D), 0.01),
        'conv_pw2_w': nrm((N_ODD, D, D), D ** -0.5),
        'conv_pw2_b': nrm((N_ODD, D), 0.01),
        'router_w': nrm((DEPTH, D, N_EXPERTS), D ** -0.5),
        'router_b': nrm((DEPTH, N_EXPERTS), 0.01),
        'expert_w1': nrm((DEPTH, N_EXPERTS, D, 2 * D_EXPERT), D ** -0.5),
        'expert_b1': nrm((DEPTH, N_EXPERTS, 2 * D_EXPERT), 0.01),
        'expert_w2': nrm((DEPTH, N_EXPERTS, D_EXPERT, D), D_EXPERT ** -0.5),
        'expert_b2': nrm((DEPTH, N_EXPERTS, D), 0.01),
    }


def reference(x, c, ctx, c_ctx, ada_w, ada_b, norm_mix_g, norm_ffn_g, final_norm_g,
              mix_w_in, shift_mu_prev, shift_mu_next, decay_w0, decay_w2, iclr_a0, iclr_a2,
              gate_g2, key_k, key_a, bonus_r_k, lnx_g, lnx_b, na_rpb, mix_w_out,
              conv_pw1_w, conv_pw1_b, conv_dw_w, conv_dw_b, conv_ln_g, conv_ln_b, conv_pw2_w, conv_pw2_b,
              router_w, router_b, expert_w1, expert_b1, expert_w2, expert_b2):
    silu_c = jax.nn.silu(c)
    silu_cc = jax.nn.silu(c_ctx)
    for l in range(DEPTH):
        mod = silu_c @ ada_w[l] + ada_b[l]
        sh1, sc1, g1, sh2, sc2, g2 = jnp.split(mod[:, None, :], 6, axis=-1)
        h = _adaln(x, norm_mix_g[l], sh1, sc1)
        if l % 2 == 0:
            i = l // 2
            mod_c = silu_cc @ ada_w[l] + ada_b[l]
            hc = _adaln(ctx, norm_mix_g[l], mod_c[:D_MODEL], mod_c[D_MODEL:2 * D_MODEL])
            y = _even_mixer(h, hc, mix_w_in[i], shift_mu_prev[i], shift_mu_next[i], decay_w0[i], decay_w2[i],
                            iclr_a0[i], iclr_a2[i], gate_g2[i], key_k[i], key_a[i], bonus_r_k[i],
                            lnx_g[i], lnx_b[i], na_rpb[i], mix_w_out[i])
        else:
            i = l // 2
            y = _conformer_conv(h, conv_pw1_w[i], conv_pw1_b[i], conv_dw_w[i], conv_dw_b[i],
                                conv_ln_g[i], conv_ln_b[i], conv_pw2_w[i], conv_pw2_b[i])
        x = x + g1 * y
        x = x + g2 * _moe(_adaln(x, norm_ffn_g[l], sh2, sc2), router_w[l], router_b[l],
                          expert_w1[l], expert_b1[l], expert_w2[l], expert_b2[l])
    return _rmsnorm(x, final_norm_g)
```

```cpp
#include <hip/hip_runtime.h>
#include <cstdio>
#include <cstdint>

#define GAS __attribute__((address_space(1)))
#define LAS __attribute__((address_space(3)))
typedef unsigned short bf16;
typedef short bf16x8 __attribute__((ext_vector_type(8)));
typedef float f32x4 __attribute__((ext_vector_type(4)));
typedef float f32x2 __attribute__((ext_vector_type(2)));
typedef unsigned u32x4 __attribute__((ext_vector_type(4)));
typedef unsigned u32x2 __attribute__((ext_vector_type(2)));

__device__ __forceinline__ unsigned f2bf(float f) { unsigned u = __builtin_bit_cast(unsigned, f); return (u + 0x7fffu + ((u >> 16) & 1u)) >> 16; }
__device__ __forceinline__ unsigned pk2(float lo, float hi) { return f2bf(lo) | (f2bf(hi) << 16); }
__device__ __forceinline__ float bflo(unsigned u) { return __builtin_bit_cast(float, u << 16); }
__device__ __forceinline__ float bfhi(unsigned u) { return __builtin_bit_cast(float, u & 0xffff0000u); }
__device__ __forceinline__ float sigmoidf_(float x) { return __builtin_amdgcn_rcpf(1.0f + __expf(-x)); }
__device__ __forceinline__ float wave_sum(float v) {
#pragma unroll
    for (int o = 1; o < 64; o <<= 1) v += __shfl_xor(v, o);
    return v;
}

namespace pg8 {
constexpr int BM = 256, BK = 64, HALF = 128, HTB = HALF * BK * 2, STAGE_BYTES = 8 * HTB, NXCD = 8, WGM = 4;
__host__ __device__ __forceinline__ int lds_byte(int r, int c) { const int st = (r >> 4) * 2 + (c >> 5), rr = r & 15, cc = c & 31, ob = rr * 64 + cc * 2; return st * 1024 + (ob ^ (((ob >> 9) & 1) << 5)); }
__host__ __device__ __forceinline__ void stage_rc(int b, int& R, int& C) { const int st = b / 1024, sb = b % 1024, swz = sb ^ (((sb >> 9) & 1) << 5); R = (st >> 1) * 16 + swz / 64; C = (st & 1) * 32 + (swz % 64) / 2; }
__host__ __device__ __forceinline__ int perm32(int rho) { const int n = rho >> 4, i = rho & 15; return 8 * (i >> 2) + 4 * n + (i & 3); }

struct Unit { int pm, pn, e; };

struct OrderBase {
    int nM, nN, nwg, G, c, reps;
    __device__ __forceinline__ void init(int nM_, int nN_, int G_, int c_) { nM = nM_; nN = nN_; nwg = nM * nN; G = G_; c = c_; reps = 1; }
    __device__ __forceinline__ bool next(int i, Unit& u) const {
#ifdef PROBE_DUP
        const long L = (long)(i >> 1) * G + c; if (L >= (long)nwg * reps) return false;
#else
        const long L = (long)i * G + c; if (L >= (long)nwg * reps) return false;
#endif
        int wgid = (int)(L % nwg); { const int q = nwg / NXCD, r = nwg % NXCD, xcd = wgid % NXCD, off = wgid / NXCD; wgid = (xcd < r ? xcd * (q + 1) : r * (q + 1) + (xcd - r) * q) + off; }
        const int nig = WGM * nN, gid = wgid / nig, fm = gid * WGM, gsz = (nM - fm) < WGM ? (nM - fm) : WGM;
        u.pm = fm + ((wgid % nig) % gsz); u.pn = (wgid % nig) / gsz; return true;
    }
};
struct OrderPlain : OrderBase {
    static constexpr bool HAS_E = false;
    const char* A; const char* Bt; size_t tstep;
    __device__ __forceinline__ const char* a_base(const Unit& u) const { return A + (size_t)u.pm * tstep; }
    __device__ __forceinline__ const char* b_base(const Unit& u) const { return Bt + (size_t)u.pn * tstep; }
    __device__ __forceinline__ const int* a_rows(const Unit&) const { return nullptr; }
};
struct OrderMoe : OrderBase {
    static constexpr bool HAS_E = true;
    const char* A; const char* Bt; size_t tstep, estride; const int* tile_e; const int* slot_tok;
    __device__ __forceinline__ const char* a_base(const Unit& u) const { return A + (size_t)u.pm * tstep; }
    __device__ __forceinline__ const char* b_base(const Unit& u) const { return Bt + (size_t)u.e * estride + (size_t)u.pn * tstep; }
    __device__ __forceinline__ const int* a_rows(const Unit& u) const { return slot_tok + u.pm * 256; }
};

typedef __bf16 bf16x2_t __attribute__((ext_vector_type(2)));
__device__ __forceinline__ unsigned cvt_pk_bf16(float lo, float hi) { const f32x2 v = {lo, hi}; return __builtin_bit_cast(unsigned, __builtin_convertvector(v, bf16x2_t)); }

typedef int i32x8 __attribute__((ext_vector_type(8)));
typedef int i32x4 __attribute__((ext_vector_type(4)));
__device__ __forceinline__ i32x8 cat8(bf16x8 lo, bf16x8 hi) { const i32x4 a = __builtin_bit_cast(i32x4, lo), b = __builtin_bit_cast(i32x4, hi); return __builtin_shufflevector(a, b, 0, 1, 2, 3, 4, 5, 6, 7); }
template <class Epi, class Sched, bool GATHER, bool FP8 = false>
__device__ __forceinline__ void gemm_phase(LAS unsigned char* lds, const int K, const Sched& S, const Epi& E, int tid) {
    asm volatile("" : "+v"(tid));
    const int wid = __builtin_amdgcn_readfirstlane(tid >> 6), lane = tid & 63, wr = wid >> 2, wc = wid & 3, fr = lane & 15, fq = lane >> 4;
    const int nt = K / BK;
    unsigned voffA[2], voffB[2]; int gR[2]; unsigned gC[2];
#pragma unroll
    for (int i = 0; i < 2; ++i) { int R, C; stage_rc(tid * 16 + i * 8192, R, C); const int Rw = Epi::WIDE ? 64 * (R >> 5) : (R & ~31); const int Rb = Rw + (Epi::PERM ? perm32(R & 31) : (R & 31));
        voffA[i] = (unsigned)(R * K + C) * 2u; voffB[i] = (unsigned)(Rb * K + C) * 2u; gR[i] = R; gC[i] = (unsigned)C * 2u; }
    const size_t kstep = (size_t)(BK * 2);
    const size_t hstep = (size_t)HALF * K * 2;
    const size_t hstepB = Epi::WIDE ? (size_t)32 * K * 2 : hstep;
    const unsigned ldsw = (unsigned)wid * 1024u;
    const int aoff = lds_byte(wr * 64 + fr, fq * 8), boff = lds_byte(wc * 32 + fr, fq * 8);
#define PG8_SA(b, h) (((b) * 2 + (h)) * HTB)
#define PG8_SB(b, h) ((4 + (b) * 2 + (h)) * HTB)
#define PG8_STAGE(bufoff, gbase, voff) do { _Pragma("unroll") for (int _i = 0; _i < 2; ++_i) \
        __builtin_amdgcn_global_load_lds((const unsigned*)((const char*)(gbase) + (voff)[_i]), (LAS unsigned*)(lds + (bufoff) + ldsw + _i * 8192), 16, 0, 0); } while (0)
#define PG8_STAGE_A(bufoff, base, h, nx) do { if constexpr (GATHER) { if (nx) PG8_STAGE(bufoff, base, go2[h]); else PG8_STAGE(bufoff, base, goc[h]); } \
        else PG8_STAGE(bufoff, (base) + (h) * hstep, voffA); } while (0)
#define PG8_LDA(dst, b, h) do { _Pragma("unroll") for (int m = 0; m < 4; ++m) dst[m] = cat8(*(const LAS bf16x8*)(lds + PG8_SA(b, h) + aoff + m * 2048), *(const LAS bf16x8*)(lds + PG8_SA(b, h) + aoff + m * 2048 + 1024)); } while (0)
#define PG8_LDB(dst, b, h) do { _Pragma("unroll") for (int n = 0; n < 2; ++n) dst[n] = cat8(*(const LAS bf16x8*)(lds + PG8_SB(b, h) + boff + n * 2048), *(const LAS bf16x8*)(lds + PG8_SB(b, h) + boff + n * 2048 + 1024)); } while (0)
#define PG8_LO(x) __builtin_bit_cast(bf16x8, __builtin_shufflevector(x, x, 0, 1, 2, 3))
#define PG8_HI(x) __builtin_bit_cast(bf16x8, __builtin_shufflevector(x, x, 4, 5, 6, 7))
#define PG8_MMA(ai, bj, At, Bt) do { __builtin_amdgcn_s_setprio(1); _Pragma("unroll") for (int m = 0; m < 4; ++m) _Pragma("unroll") for (int n = 0; n < 2; ++n) { \
        if constexpr (FP8) asm volatile("v_mfma_f32_16x16x128_f8f6f4 %0, %1, %2, %0" : "+v"(acc[ai][bj][m][n]) : "v"(Bt[n]), "v"(At[m])); \
        else { acc[ai][bj][m][n] = __builtin_amdgcn_mfma_f32_16x16x32_bf16(PG8_LO(Bt[n]), PG8_LO(At[m]), acc[ai][bj][m][n], 0, 0, 0); \
               acc[ai][bj][m][n] = __builtin_amdgcn_mfma_f32_16x16x32_bf16(PG8_HI(Bt[n]), PG8_HI(At[m]), acc[ai][bj][m][n], 0, 0, 0); } } \
        __builtin_amdgcn_s_setprio(0); } while (0)
#define PG8_MMAZ(ai, bj, At, Bt) do { __builtin_amdgcn_s_setprio(1); _Pragma("unroll") for (int m = 0; m < 4; ++m) _Pragma("unroll") for (int n = 0; n < 2; ++n) { \
        if constexpr (FP8) asm volatile("v_mfma_f32_16x16x128_f8f6f4 %0, %1, %2, 0" : "=&v"(acc[ai][bj][m][n]) : "v"(Bt[n]), "v"(At[m])); \
        else { acc[ai][bj][m][n] = __builtin_amdgcn_mfma_f32_16x16x32_bf16(PG8_LO(Bt[n]), PG8_LO(At[m]), (f32x4){0.f, 0.f, 0.f, 0.f}, 0, 0, 0); \
               acc[ai][bj][m][n] = __builtin_amdgcn_mfma_f32_16x16x32_bf16(PG8_HI(Bt[n]), PG8_HI(At[m]), acc[ai][bj][m][n], 0, 0, 0); } } \
        __builtin_amdgcn_s_setprio(0); } while (0)
#define PG8_WAIT_V(n) asm volatile("s_waitcnt vmcnt(" #n ")" ::: "memory")
#define PG8_WAIT_L(n) asm volatile("s_waitcnt lgkmcnt(" #n ")" ::: "memory")
#define PG8_BAR __builtin_amdgcn_s_barrier()
#define PG8_SCHED __builtin_amdgcn_sched_barrier(0)
#define PG8_GOFF(dst, rows) do { _Pragma("unroll") for (int _h = 0; _h < 2; ++_h) _Pragma("unroll") for (int _i = 0; _i < 2; ++_i) \
        dst[_h][_i] = (unsigned)(rows)[_h * HALF + gR[_i]] * (unsigned)(K * 2) + gC[_i]; } while (0)
    Unit cur, nxt; int ui = 0;
    if (!S.next(0, cur)) return;
    cur.e = 0; if constexpr (Sched::HAS_E) cur.e = __builtin_amdgcn_readfirstlane(S.tile_e[cur.pm]);
    f32x4 acc[2][2][4][2];
    i32x8 At[4], B0[2], B1[2];
    const int fp8_one = 0x7f7f7f7f;
    unsigned goc[2][2], gon[2][2], go2[2][2];
    const char* cA = GATHER ? S.A : S.a_base(cur); const char* cB = S.b_base(cur);
    if constexpr (GATHER) { const int* rows = S.a_rows(cur); PG8_GOFF(goc, rows);
#pragma unroll
        for (int h = 0; h < 2; ++h)
#pragma unroll
            for (int i = 0; i < 2; ++i) { gon[h][i] = goc[h][i]; go2[h][i] = goc[h][i]; } }
    PG8_STAGE(PG8_SB(0, 0), cB, voffB); PG8_STAGE(PG8_SB(0, 1), cB + hstepB, voffB); PG8_STAGE_A(PG8_SA(0, 0), cA, 0, 0); PG8_STAGE_A(PG8_SA(0, 1), cA, 1, 0);
    if (wr == 1) PG8_BAR;
    PG8_WAIT_V(2); PG8_BAR;
    PG8_STAGE(PG8_SB(1, 0), cB + kstep, voffB); PG8_STAGE_A(PG8_SA(1, 0), cA + kstep, 0, 0); PG8_STAGE(PG8_SB(1, 1), cB + hstepB + kstep, voffB);
    PG8_WAIT_V(6); PG8_BAR;
    for (;;) {
        const bool has_next = S.next(ui + 1, nxt);
        nxt.e = cur.e; if constexpr (Sched::HAS_E) { if (has_next) { const int* ep = S.tile_e + nxt.pm; int ev; asm volatile("global_load_dword %0, %1, off" : "=v"(ev) : "v"(ep) : "memory"); nxt.e = ev; } }
        const char* nA = has_next ? (GATHER ? S.A : S.a_base(nxt)) : cA;
#define PG8_TRIP(MMAF) do { \
            const bool last = (t == nt - 2); \
            const char* a1 = cA + (size_t)(t + 1) * kstep; \
            const char* nB = cB; if (last && has_next) { if constexpr (Sched::HAS_E) { int ev = nxt.e; asm volatile("" : "+v"(ev)); nxt.e = __builtin_amdgcn_readfirstlane(ev); } \
                nB = S.b_base(nxt); } \
            const char* a2 = last ? nA : cA + (size_t)(t + 2) * kstep; const char* b2 = last ? nB : cB + (size_t)(t + 2) * kstep; \
            const char* a3 = a2 + kstep; const char* b3 = b2 + kstep; \
            if constexpr (GATHER) { \
                if (t == 0 && has_next) { const int* rows = S.a_rows(nxt); \
_Pragma("unroll") \
                    for (int h = 0; h < 2; ++h) \
_Pragma("unroll") \
                        for (int i = 0; i < 2; ++i) { const int* rp = rows + h * HALF + gR[i]; unsigned rv; asm volatile("global_load_dword %0, %1, off" : "=v"(rv) : "v"(rp) : "memory"); gon[h][i] = rv; } } \
                if (last && has_next) { \
_Pragma("unroll") \
                    for (int h = 0; h < 2; ++h) \
_Pragma("unroll") \
                        for (int i = 0; i < 2; ++i) { unsigned rv = gon[h][i]; asm volatile("" : "+v"(rv)); gon[h][i] = rv * (unsigned)(K * 2) + gC[i]; go2[h][i] = gon[h][i]; } } \
            } \
            PG8_LDB(B0, 0, 0); PG8_LDB(B1, 0, 1); PG8_SCHED; PG8_LDA(At, 0, 0); PG8_STAGE_A(PG8_SA(1, 1), a1, 1, 0); \
            PG8_WAIT_V(8); PG8_WAIT_L(0); PG8_BAR; MMAF(0, 0, At, B0); MMAF(0, 1, At, B1); PG8_BAR; PG8_SCHED; \
            PG8_LDA(At, 0, 1); PG8_STAGE(PG8_SB(0, 0), b2, voffB); PG8_STAGE(PG8_SB(0, 1), b2 + hstepB, voffB); PG8_STAGE_A(PG8_SA(0, 0), a2, 0, 1); \
            PG8_WAIT_V(8); PG8_WAIT_L(0); PG8_BAR; MMAF(1, 0, At, B0); MMAF(1, 1, At, B1); PG8_BAR; PG8_SCHED; \
            PG8_LDB(B0, 1, 0); PG8_LDB(B1, 1, 1); PG8_SCHED; PG8_LDA(At, 1, 0); PG8_STAGE_A(PG8_SA(0, 1), a2, 1, 1); \
            PG8_WAIT_V(8); PG8_WAIT_L(0); PG8_BAR; PG8_MMA(0, 0, At, B0); PG8_MMA(0, 1, At, B1); PG8_BAR; PG8_SCHED; \
            PG8_LDA(At, 1, 1); PG8_STAGE(PG8_SB(1, 0), b3, voffB); PG8_STAGE(PG8_SB(1, 1), b3 + hstepB, voffB); PG8_STAGE_A(PG8_SA(1, 0), a3, 0, 1); \
            PG8_WAIT_V(8); PG8_WAIT_L(0); PG8_BAR; PG8_MMA(1, 0, At, B0); PG8_MMA(1, 1, At, B1); PG8_BAR; PG8_SCHED; \
        } while (0)
        { const int t = 0; PG8_TRIP(PG8_MMAZ); }
#pragma unroll 1
        for (int t = 2; t < nt; t += 2) { PG8_TRIP(PG8_MMA); }
#undef PG8_TRIP
        if constexpr (FP8) asm volatile("s_nop 15\n\ts_nop 15\n\ts_nop 15" ::: "memory");
        const typename Epi::Pre pre = E.pre(cur, wr, wc);
        if (wr == 0) PG8_BAR;
#ifdef PROBE_DUP
        if (PROBE_DUP == 2 || (ui & 1))
#endif
        E(acc, cur, wr, wc, fr, fq, pre);
#ifdef PROBE_EPI2
        if constexpr (FP8 && (GATHER ? (PROBE_EPI2 & 1) : (PROBE_EPI2 & 2)) != 0) { int fr2 = fr, fq2 = fq; asm volatile("" : "+v"(fr2), "+v"(fq2) :: "memory"); E(acc, cur, wr, wc, fr2, fq2, pre); }
#endif
        if (!has_next) break;
        cur = nxt; cA = nA; cB = S.b_base(nxt); ++ui;
        if constexpr (GATHER) {
#pragma unroll
            for (int h = 0; h < 2; ++h)
#pragma unroll
                for (int i = 0; i < 2; ++i) { goc[h][i] = gon[h][i]; go2[h][i] = gon[h][i]; } }
        if (wr == 1) PG8_BAR;
    }
    PG8_WAIT_V(0);
    PG8_BAR;
#undef PG8_SA
#undef PG8_SB
#undef PG8_STAGE
#undef PG8_STAGE_A
#undef PG8_LDA
#undef PG8_LDB
#undef PG8_LO
#undef PG8_HI
#undef PG8_MMA
#undef PG8_MMAZ
#undef PG8_WAIT_V
#undef PG8_WAIT_L
#undef PG8_BAR
#undef PG8_SCHED
#undef PG8_GOFF
}
}

constexpr int NWAVES = 8, NTHR = 512;
constexpr int D = 1024, NB = 16, T = 2048, NTOK = NB * T, CTXL = 256, NCTX = NB * CTXL, MROWS = NTOK + NCTX;
constexpr int PW = 3072;
constexpr int NIN = 3584;
constexpr int PC_RA = 1024, PC_GD = 1536, PC_KA = 1664, PC_VA = 2176, PC_WD = 2688, PC_AD = 2816;
constexpr int TT = CTXL + T;
constexpr int NE = 32, TOPK = 4, NPAIR = NTOK * TOPK, MAXTILES = 544, MAXSLOTS = MAXTILES * 256;
constexpr int NCHUNK = 256, CHUNK_ROWS = NTOK / NCHUNK;

#ifndef PROBE_R_PRO
#define PROBE_R_PRO 1
#endif
#ifndef PROBE_R_TERMS
#define PROBE_R_TERMS 1
#endif
#ifndef PROBE_R_SCAN
#define PROBE_R_SCAN 1
#endif
#ifndef PROBE_R_NA
#define PROBE_R_NA 1
#endif
#ifdef PROBE_NA_FAKE
#define PROBE_R_NA 2
#endif
#ifdef PROBE_COMB_FAKE
#define PROBE_R_COMB 2
#endif
#ifdef PROBE_CSLEEP
#define PROBE_CONS_SLEEP __builtin_amdgcn_s_sleep(2)
#else
#define PROBE_CONS_SLEEP do {} while (0)
#endif
#ifndef PROBE_R_MOEG
#define PROBE_R_MOEG 1
#endif
#ifndef PROBE_R_DENSE
#define PROBE_R_DENSE 1
#endif
#ifndef PROBE_R_DENSE2
#define PROBE_R_DENSE2 1
#endif
#ifndef PROBE_R_ADALN
#define PROBE_R_ADALN 1
#endif
#ifndef PROBE_R_POST
#define PROBE_R_POST 1
#endif
#ifndef PROBE_R_CONV
#define PROBE_R_CONV 1
#endif
#ifndef PROBE_R_COMB
#define PROBE_R_COMB 1
#endif
#ifndef PROBE_R_ROUTER
#define PROBE_R_ROUTER 1
#endif
constexpr size_t MiB = 1u << 20;
constexpr size_t WS_CTL = 0, CTL_ZERO_BYTES = 1 * MiB;
constexpr size_t WS_MOD = 1 * MiB;
constexpr size_t WS_SMALLW = 2 * MiB;
constexpr size_t WS_ROUTE = 3 * MiB;
constexpr size_t WS_WIN = 8 * MiB, WS_WOUT = 15 * MiB, WS_PW1 = 17 * MiB, WS_PW2 = 21 * MiB;
constexpr size_t WS_EW1 = 24 * MiB, WS_EW2 = 280 * MiB;
constexpr size_t WS_H = 408 * MiB;
constexpr size_t WS_P = 480 * MiB;
constexpr size_t WS_VT = 696 * MiB;
constexpr size_t WS_SD = 732 * MiB;
constexpr size_t WS_SS = 1308 * MiB;
constexpr size_t WS_SCL = 1452 * MiB;
constexpr size_t WS_Y = 1457 * MiB;
constexpr size_t WS_GB = 1585 * MiB;
constexpr size_t WS_X1 = 1649 * MiB;
constexpr size_t WS_END = 1777 * MiB;
constexpr size_t WS_KB = WS_SS;
constexpr size_t WS_BON1 = WS_SD;
constexpr size_t WS_ACT = WS_SD, WS_YB = WS_SD + 272 * MiB, WS_GLU = WS_P;
static_assert(WS_YB + (size_t)MAXSLOTS * D * 2 <= WS_SS && WS_ACT + (size_t)MAXSLOTS * D * 2 <= WS_YB, "ws map");
constexpr size_t RT_CNT = WS_ROUTE;
constexpr size_t RT_TOKE = RT_CNT + 32768;
constexpr size_t RT_RANK = RT_TOKE + 524288;
constexpr size_t RT_GATE = RT_RANK + 524288;
constexpr size_t RT_PSLOT = RT_GATE + 524288;
constexpr size_t RT_STOK = RT_PSLOT + 524288;
constexpr size_t RT_TILEE = RT_STOK + 589824;
static_assert(RT_TILEE + 4096 <= WS_WIN, "route map");
constexpr int CW_BAR = 4096;

constexpr int RING_BYTES = 131072, LDS_BYTES = 163840, LDSCTL_OFF = LDS_BYTES - 2048;

#define RLX_AGENT __ATOMIC_RELAXED, __HIP_MEMORY_SCOPE_AGENT

#define XB_TMO      128
#define XB_XCNT(j)  (256  + 64 * (j))
#define XB_XSUB(j)  (1280 + 64 * (j))
#define XB_XGEN(j)  (2304 + 64 * (j))
#define XB_TOP      3328
#define XB_TOPGEN   3392
#define XCD_BAR_WORDS 3456
#define XB_SPIN_CAP (1u << 18)
__device__ __forceinline__ unsigned xb_ld(unsigned* p)              { return __hip_atomic_load(p, __ATOMIC_RELAXED, __HIP_MEMORY_SCOPE_AGENT); }
__device__ __forceinline__ unsigned xb_add(unsigned* p, unsigned v) { return __hip_atomic_fetch_add(p, v, __ATOMIC_RELAXED, __HIP_MEMORY_SCOPE_AGENT); }
__device__ __forceinline__ unsigned xb_xcc_id() { return (unsigned)__builtin_amdgcn_s_getreg((3 << 11) | 20) & 0xFu; }
#define XB_SPIN(cond, bar) do { unsigned _sp = 0; while (cond) { __builtin_amdgcn_s_sleep(1); \
    if ((++_sp & 255u) == 0u) { if (xb_ld(&(bar)[XB_TMO])) break; if (_sp > XB_SPIN_CAP) { atomicAdd(&(bar)[XB_TMO], 1u); break; } } } } while (0)
struct XcdBarrier { unsigned* bar; unsigned x; volatile LAS unsigned* st; };
__device__ __forceinline__ XcdBarrier xcd_barrier_post(unsigned* bar, volatile LAS unsigned* st, bool t0) {
    XcdBarrier b; b.bar = bar; b.x = xb_xcc_id(); b.st = st;
    if (t0) (void)xb_add(&bar[XB_XCNT(b.x)], 1u);
    return b;
}
__device__ __forceinline__ void xcd_barrier_complete(unsigned* bar, unsigned x, unsigned& nloc, unsigned& nx) {
    const unsigned G = gridDim.x * gridDim.y * gridDim.z;
    unsigned sum, cnt, mine, sp = 0u;
    for (;;) {
        sum = 0u; cnt = 0u; mine = 0u;
#pragma unroll
        for (unsigned j = 0; j < 16; ++j) { const unsigned c = xb_ld(&bar[XB_XCNT(j)]); sum += c; cnt += (c > 0u) ? 1u : 0u; mine = (j == x) ? c : mine; }
        if (sum == G) break;
        __builtin_amdgcn_s_sleep(1);
        if ((++sp & 255u) == 0u) { if (xb_ld(&bar[XB_TMO])) break; if (sp > XB_SPIN_CAP) { atomicAdd(&bar[XB_TMO], 1u); break; } }
    }
    nloc = mine > 0u ? mine : 1u; nx = cnt > 0u ? cnt : 1u;
}
__device__ __forceinline__ void xcd_barrier(const XcdBarrier& b, bool t0) {
    asm volatile("s_waitcnt vmcnt(0)" ::: "memory");
    __syncthreads();
    if (t0) {
        unsigned* bar = b.bar;
        __builtin_amdgcn_s_waitcnt(0);
        unsigned nloc = b.st[0], nx = b.st[1];
        if (nloc == 0u) { xcd_barrier_complete(bar, b.x, nloc, nx); b.st[0] = nloc; b.st[1] = nx; }
        const unsigned old = xb_add(&bar[XB_XSUB(b.x)], 1u);
        const unsigned gen = old / nloc;
        if (old + 1u == (gen + 1u) * nloc) {
            __builtin_amdgcn_fence(__ATOMIC_RELEASE, "agent");
            asm volatile("s_waitcnt vmcnt(0)" ::: "memory");
            const unsigned og = xb_add(&bar[XB_TOP], 1u);
            const unsigned tg = og / nx;
            if (og + 1u == (tg + 1u) * nx) xb_add(&bar[XB_TOPGEN], 1u);
            else XB_SPIN(xb_ld(&bar[XB_TOPGEN]) == tg, bar);
            __builtin_amdgcn_fence(__ATOMIC_ACQUIRE, "agent");
            xb_add(&bar[XB_XGEN(b.x)], 1u);
            asm volatile("s_waitcnt vmcnt(0)" ::: "memory");
        } else {
            XB_SPIN(xb_ld(&bar[XB_XGEN(b.x)]) == gen, bar);
            __builtin_amdgcn_fence(__ATOMIC_ACQUIRE, "agent");
            asm volatile("s_waitcnt vmcnt(0)" ::: "memory");
        }
    }
    __syncthreads();
}

struct Args { const float* in[38]; float* out; unsigned char* ws; int ph_lo, ph_hi; };
enum { I_X = 0, I_C, I_CTX, I_CCTX, I_ADAW, I_ADAB, I_NMIXG, I_NFFNG, I_FING, I_WIN, I_MUP, I_MUN, I_W0, I_W2, I_A0, I_A2, I_G2, I_KK, I_KA, I_RK, I_LNXG, I_LNXB, I_RPB, I_WOUT,
       I_PW1W, I_PW1B, I_DWW, I_DWB, I_CLNG, I_CLNB, I_PW2W, I_PW2B, I_RW, I_RB, I_EW1, I_EB1, I_EW2, I_EB2 };

typedef const __attribute__((address_space(4))) Args* ArgP;
__device__ __forceinline__ int lane_id() { int x; asm volatile("v_mbcnt_lo_u32_b32 %0, -1, 0\n\tv_mbcnt_hi_u32_b32 %0, -1, %0" : "=v"(x)); return x; }
struct Ctx { LAS unsigned char* lds; int tid, lane, wave, vcu, G; };
constexpr float Q_SW = 64.0f, Q_SA = 8.0f, Q_SA2 = 4.0f;
__device__ __forceinline__ unsigned pk4_fp8(float a, float b, float c, float d) { unsigned r = 0; r = __builtin_amdgcn_cvt_pk_fp8_f32(a, b, r, false); r = __builtin_amdgcn_cvt_pk_fp8_f32(c, d, r, true); return r; }
__device__ __forceinline__ void st16_wt(void* p, u32x4 v) { asm volatile("global_store_dwordx4 %0, %1, off sc1\n\ts_nop 1" :: "v"(p), "v"(v) : "memory"); }

__device__ __forceinline__ void p0_transpose_item(const float* W, int K, int N, bf16* WT, int k0, int n0, int roff, int rmul, LAS float* scr, int lane) {
    float wv_[32];
#pragma unroll
    for (int i = 0; i < 32; ++i) wv_[i] = W[(size_t)(k0 + 2 * i + (lane >> 5)) * N + n0 + (lane & 31)];
#pragma unroll
    for (int i = 0; i < 32; ++i) scr[(2 * i + (lane >> 5)) * 33 + (lane & 31)] = wv_[i];
    asm volatile("s_waitcnt lgkmcnt(0)" ::: "memory");
    const int c = lane & 7;
#pragma unroll
    for (int j = 0; j < 4; ++j) { const int n = (lane >> 3) + 8 * j; const LAS float* s = scr + (8 * c) * 33 + n;
        u32x4 o; o.x = pk2(s[0 * 33], s[1 * 33]); o.y = pk2(s[2 * 33], s[3 * 33]); o.z = pk2(s[4 * 33], s[5 * 33]); o.w = pk2(s[6 * 33], s[7 * 33]);
        *(u32x4*)(WT + (size_t)(roff + n * rmul) * K + k0 + 8 * c) = o; }
    asm volatile("s_waitcnt lgkmcnt(0)" ::: "memory");
}
__device__ __forceinline__ void p0_transpose_item_f8(const float* W, int K, int N, unsigned char* WT, int k0, int n0, int roff, int rmul, LAS float* scr, int lane) {
    float wv_[32];
#pragma unroll
    for (int i = 0; i < 32; ++i) wv_[i] = W[(size_t)(k0 + 2 * i + (lane >> 5)) * N + n0 + (lane & 31)];
#pragma unroll
    for (int i = 0; i < 32; ++i) scr[(2 * i + (lane >> 5)) * 33 + (lane & 31)] = wv_[i];
    asm volatile("s_waitcnt lgkmcnt(0)" ::: "memory");
    const int c = lane & 7;
#pragma unroll
    for (int j = 0; j < 4; ++j) { const int n = (lane >> 3) + 8 * j; const LAS float* s = scr + (8 * c) * 33 + n;
        u32x2 o; o.x = pk4_fp8(s[0 * 33] * Q_SW, s[1 * 33] * Q_SW, s[2 * 33] * Q_SW, s[3 * 33] * Q_SW); o.y = pk4_fp8(s[4 * 33] * Q_SW, s[5 * 33] * Q_SW, s[6 * 33] * Q_SW, s[7 * 33] * Q_SW);
        *(u32x2*)(WT + (size_t)(roff + n * rmul) * K + k0 + 8 * c) = o; }
    asm volatile("s_waitcnt lgkmcnt(0)" ::: "memory");
}

constexpr int XI_A = 64 * 1024, XI_B = 64 * 512, XI_N = XI_A + XI_B;
__device__ __forceinline__ void p0_expert_item(ArgP a, int r, LAS float* scr, int lane) {
    unsigned char* ws = a->ws;
    if (r < XI_A) { const int mi = r >> 10, q = r & 1023, kb = q >> 6, nb = q & 63;
        p0_transpose_item(a->in[I_EW1] + (size_t)mi * 1024 * 2048, 1024, 2048, (bf16*)(ws + WS_EW1) + (size_t)mi * 2048 * 1024, kb * 64, nb * 32, nb * 32, 1, scr, lane); }
    else { r -= XI_A; const int mi = r >> 9, q = r & 511, kb = q >> 5, nb = q & 31;
        p0_transpose_item(a->in[I_EW2] + (size_t)mi * 1024 * 1024, 1024, 1024, (bf16*)(ws + WS_EW2) + (size_t)mi * 1024 * 1024, kb * 64, nb * 32, nb * 32, 1, scr, lane); }
}

__device__ __forceinline__ void p0_prologue(ArgP a, const Ctx& F) {
    unsigned char* ws = a->ws;
    if (F.vcu < 192) {
        LAS float* SC = (LAS float*)F.lds; LAS float* RED = (LAS float*)(F.lds + 17 * 1024 * 4);
        {   float tv[34];
#pragma unroll
            for (int q = 0; q < 34; ++q) tv[q] = q < 32 ? a->in[I_C][F.tid + NTHR * q] : a->in[I_CCTX][F.tid + NTHR * (q - 32)];
#pragma unroll
            for (int q = 0; q < 34; ++q) SC[F.tid + NTHR * q] = tv[q] * sigmoidf_(tv[q]); }
        __syncthreads();
        const int l = F.vcu / 96, jb = F.vcu % 96, j = jb * 64 + F.lane;
        const float* W = a->in[I_ADAW] + (size_t)l * 1024 * 6144 + j;
        float acc[17];
#pragma unroll
        for (int b = 0; b < 17; ++b) acc[b] = 0.f;
        {
            const int kb = F.wave * 128;
            float wq[8], wn[8];
#pragma unroll
            for (int i = 0; i < 8; ++i) wn[i] = W[(size_t)(kb + i) * 6144];
#pragma unroll 1
            for (int k = kb; k < kb + 128; k += 8) {
#pragma unroll
                for (int i = 0; i < 8; ++i) wq[i] = wn[i];
                const int kn = (k + 8 < kb + 128) ? k + 8 : kb;
#pragma unroll
                for (int i = 0; i < 8; ++i) wn[i] = W[(size_t)(kn + i) * 6144];
                __builtin_amdgcn_sched_barrier(0);
#pragma unroll
                for (int b = 0; b < 17; ++b) { const f32x4 s0 = *(const LAS f32x4*)(SC + b * 1024 + k), s1 = *(const LAS f32x4*)(SC + b * 1024 + k + 4);
                    acc[b] += (s0.x * wq[0] + s0.y * wq[1] + s0.z * wq[2] + s0.w * wq[3]) + (s1.x * wq[4] + s1.y * wq[5] + s1.z * wq[6] + s1.w * wq[7]); }
            }
        }
#pragma unroll
        for (int b = 0; b < 17; ++b) RED[(F.wave * 17 + b) * 64 + F.lane] = acc[b];
        __syncthreads();
        float* mod = (float*)(ws + WS_MOD);
        for (int idx = F.tid; idx < 17 * 64; idx += NTHR) { const int b = idx >> 6, jl = idx & 63; float s = 0.f;
#pragma unroll
            for (int w = 0; w < 8; ++w) s += RED[(w * 17 + b) * 64 + jl];
            const int jj = jb * 64 + jl; s += a->in[I_ADAB][l * 6144 + jj];
            if (b < 16) mod[(size_t)(l * 16 + b) * 6144 + jj] = s; else if (l == 0) mod[2 * 16 * 6144 + jj] = s; }
        __syncthreads();
    }
    LAS float* scr = (LAS float*)(F.lds + F.wave * 16384);
    const int gw = F.vcu * NWAVES + F.wave, NGW = F.G * NWAVES;
    constexpr int I_A = 64 * 1024, I_B = 64 * 512, I_Cc = 16 * 108, I_D = 512, I_E = 1024, I_F = 512, I_G = 96;
    constexpr int NITEMS = I_A + I_B + I_Cc + I_D + I_E + I_F + I_G;
    for (int it = gw + I_A + I_B; it < NITEMS; it += NGW) {
        int r = it;
        if (r < I_A) { const int mi = r >> 10, q = r & 1023, kb = q >> 6, nb = q & 63;
            p0_transpose_item(a->in[I_EW1] + (size_t)mi * 1024 * 2048, 1024, 2048, (bf16*)(ws + WS_EW1) + (size_t)mi * 2048 * 1024, kb * 64, nb * 32, nb * 32, 1, scr, F.lane); continue; } r -= I_A;
        if (r < I_B) { const int mi = r >> 9, q = r & 511, kb = q >> 5, nb = q & 31;
            p0_transpose_item(a->in[I_EW2] + (size_t)mi * 1024 * 1024, 1024, 1024, (bf16*)(ws + WS_EW2) + (size_t)mi * 1024 * 1024, kb * 64, nb * 32, nb * 32, 1, scr, F.lane); continue; } r -= I_B;
        if (r < I_Cc) { const int kb = r / 108, nb = r % 108, n0 = nb * 32;
            const int roff = n0 < 512 ? n0 : (n0 < 2432 ? 1024 + (n0 - 512) : (n0 < 2944 ? 512 + (n0 - 2432) : 3072 + (n0 - 2944)));
            p0_transpose_item_f8(a->in[I_WIN], 1024, 3456, ws + WS_WIN, kb * 64, n0, roff, 1, scr, F.lane); continue; } r -= I_Cc;
        if (r < I_D) { const int kb = r >> 5, nb = r & 31; p0_transpose_item_f8(a->in[I_WOUT], 1024, 1024, ws + WS_WOUT, kb * 64, nb * 32, nb * 32, 1, scr, F.lane); continue; } r -= I_D;
        if (r < I_E) { const int kb = r >> 6, nb = r & 63, n0 = nb * 32;
            p0_transpose_item_f8(a->in[I_PW1W], 1024, 2048, ws + WS_PW1, kb * 64, n0, n0 < 1024 ? 2 * n0 : 2 * (n0 - 1024) + 1, 2, scr, F.lane); continue; } r -= I_E;
        if (r < I_F) { const int kb = r >> 5, nb = r & 31; p0_transpose_item_f8(a->in[I_PW2W], 1024, 1024, ws + WS_PW2, kb * 64, nb * 32, nb * 32, 1, scr, F.lane); continue; } r -= I_F;
        {   bf16* sw = (bf16*)(ws + WS_SMALLW);
            if (r < 32) { const int kb = r >> 4, nb = r & 15; p0_transpose_item(a->in[I_G2], 128, 512, sw, kb * 64, nb * 32, nb * 32, 1, scr, F.lane); }
            else if (r < 64) { const int q = r - 32, d = q >> 4, nb = q & 15; p0_transpose_item(a->in[I_W2] + d * 64 * 512, 64, 512, sw + 65536 + d * 32768, 0, nb * 32, nb * 32, 1, scr, F.lane); }
            else { const int q = r - 64, d = q >> 4, nb = q & 15; p0_transpose_item(a->in[I_A2] + d * 64 * 512, 64, 512, sw + 131072 + d * 32768, 0, nb * 32, nb * 32, 1, scr, F.lane); } }
    }
    const int gt = F.vcu * NTHR + F.tid, NGT = F.G * NTHR;
    for (int i = gt; i < 128 * 1024 / 16; i += NGT) ((u32x4*)(ws + WS_WIN + (size_t)2944 * 1024))[i] = (u32x4){0u, 0u, 0u, 0u};
    float* rwt = (float*)(ws + WS_SMALLW + 393216);
    for (int i = gt; i < 2 * 32 * 1024; i += NGT) { const int l = i >> 15, e = (i >> 10) & 31, k = i & 1023; rwt[i] = a->in[I_RW][(size_t)(l * 1024 + k) * 32 + e]; }
}

__device__ __forceinline__ void row_load(const float* p, int lane, f32x4 (&v)[4]) {
#pragma unroll
    for (int j = 0; j < 4; ++j) v[j] = ((const f32x4*)p)[lane + 64 * j];
}
__device__ __forceinline__ void row_load_b16(const bf16* p, int lane, f32x4 (&v)[4]) {
#pragma unroll
    for (int j = 0; j < 4; ++j) { const u32x2 u = ((const u32x2*)p)[lane + 64 * j]; v[j] = (f32x4){bflo(u.x), bfhi(u.x), bflo(u.y), bfhi(u.y)}; }
}
__device__ __forceinline__ float row_rstd(const f32x4 (&v)[4]) {
    float s = 0.f;
#pragma unroll
    for (int j = 0; j < 4; ++j) s += (v[j].x * v[j].x + v[j].y * v[j].y) + (v[j].z * v[j].z + v[j].w * v[j].w);
    return __frsqrt_rn(wave_sum(s) * (1.0f / D) + 1e-6f);
}
__device__ __forceinline__ void row_adaln(f32x4 (&v)[4], const float* g, const float* shift, const float* scale, int lane) {
    const float rs = row_rstd(v);
#pragma unroll
    for (int j = 0; j < 4; ++j) { const f32x4 gg = ((const f32x4*)g)[lane + 64 * j], sh = ((const f32x4*)shift)[lane + 64 * j], sc = ((const f32x4*)scale)[lane + 64 * j];
        v[j] = (v[j] * rs) * gg * (sc + 1.0f) + sh; }
}
__device__ __forceinline__ void row_store_fp8_wt(unsigned char* p, int lane, const f32x4 (&v)[4], float scale) {
    unsigned u[4];
#pragma unroll
    for (int j = 0; j < 4; ++j) u[j] = pk4_fp8(v[j].x * scale, v[j].y * scale, v[j].z * scale, v[j].w * scale);
    const bool b0 = lane & 1, b1 = lane & 2;
    const unsigned r0 = (unsigned)__shfl_xor((int)(b0 ? u[0] : u[1]), 1), r1 = (unsigned)__shfl_xor((int)(b0 ? u[2] : u[3]), 1);
    const unsigned ax = b0 ? r0 : u[0], ay = b0 ? u[1] : r0, bx = b0 ? r1 : u[2], by = b0 ? u[3] : r1;
    const unsigned t0 = (unsigned)__shfl_xor((int)(b1 ? ax : bx), 2), t1 = (unsigned)__shfl_xor((int)(b1 ? ay : by), 2);
    const u32x4 o = b1 ? (u32x4){t0, t1, bx, by} : (u32x4){ax, ay, t0, t1};
    st16_wt(p + 256 * (lane & 3) + 4 * (lane & ~3), o);
}
__device__ __forceinline__ void row_store_bf16_wt(bf16* p, int lane, const f32x4 (&v)[4]) {
    u32x2 u[4];
#pragma unroll
    for (int j = 0; j < 4; ++j) { u[j].x = pk2(v[j].x, v[j].y); u[j].y = pk2(v[j].z, v[j].w); }
    const bool b0 = lane & 1;
    u32x2 ra, rb;
    ra.x = (unsigned)__shfl_xor((int)(b0 ? u[0].x : u[1].x), 1); ra.y = (unsigned)__shfl_xor((int)(b0 ? u[0].y : u[1].y), 1);
    rb.x = (unsigned)__shfl_xor((int)(b0 ? u[2].x : u[3].x), 1); rb.y = (unsigned)__shfl_xor((int)(b0 ? u[2].y : u[3].y), 1);
    const u32x4 oa = b0 ? (u32x4){ra.x, ra.y, u[1].x, u[1].y} : (u32x4){u[0].x, u[0].y, ra.x, ra.y};
    const u32x4 ob = b0 ? (u32x4){rb.x, rb.y, u[3].x, u[3].y} : (u32x4){u[2].x, u[2].y, rb.x, rb.y};
    bf16* q = p + 256 * (lane & 1) + 4 * (lane & ~1);
    st16_wt(q, oa); st16_wt(q + 512, ob);
}
__device__ __forceinline__ void row_store_bf16(bf16* p, int lane, const f32x4 (&v)[4]) {
#pragma unroll
    for (int j = 0; j < 4; ++j) { u32x2 o; o.x = pk2(v[j].x, v[j].y); o.y = pk2(v[j].z, v[j].w); ((u32x2*)p)[lane + 64 * j] = o; }
}

__device__ __forceinline__ void p1_adaln0(ArgP a, const Ctx& F) {
    const float* mod = (const float*)(a->ws + WS_MOD); const float* modc = mod + 2 * 16 * 6144;
    bf16* H = (bf16*)(a->ws + WS_H);
    const int gw = F.vcu * NWAVES + F.wave, NGW = F.G * NWAVES;
    for (int rowr = gw; rowr < MROWS * PROBE_R_ADALN; rowr += NGW) { const int row = rowr % MROWS;
        f32x4 v[4];
        if (row < NTOK) { row_load(a->in[I_X] + (size_t)row * D, F.lane, v); const float* m = mod + (size_t)(row >> 11) * 6144; row_adaln(v, a->in[I_NMIXG], m, m + 1024, F.lane); }
        else { row_load(a->in[I_CTX] + (size_t)(row - NTOK) * D, F.lane, v); row_adaln(v, a->in[I_NMIXG], modc, modc + 1024, F.lane); }
        row_store_fp8_wt((unsigned char*)H + (size_t)row * D, F.lane, v, Q_SA);
    }
}

typedef f32x4 AccT[2][2][4][2];

constexpr int EPI_TP = 8 * pg8::HTB, EPI_TPS = 40;
struct EpiInproj {
    static constexpr bool PERM = true, WIDE = true;
    bf16* P; bf16* VT; bf16* KB; LAS unsigned char* lds;
    struct Pre {}; __device__ __forceinline__ Pre pre(const pg8::Unit&, int, int) const { return Pre{}; }
    __device__ __forceinline__ void operator()(const AccT& acc, const pg8::Unit& u, int wr, int wc, int fr, int fq, const Pre&) const {
        { const int ln = lane_id(); fr = ln & 15; fq = ln >> 4; }
        if (u.pn < 2 || (u.pn >= 4 && u.pn < 12)) {
            const float sc = ((u.pn < 2) ? 0.125f : 1.0f) * (1.0f / (Q_SA * Q_SW));
            const bool hb = fr >= 8;
            bf16* ob = P + (size_t)(u.pm * 256 + wr * 64 + (fr & 7)) * PW + u.pn * 256 + wc * 64 + 8 * fq + (hb ? 32 : 0);
#pragma unroll
            for (int ai = 0; ai < 2; ++ai)
#pragma unroll
                for (int m = 0; m < 4; ++m) { u32x4 w[2];
#pragma unroll
                    for (int bj = 0; bj < 2; ++bj) { const f32x4 v0 = acc[ai][bj][m][0] * sc, v1 = acc[ai][bj][m][1] * sc;
                        w[bj].x = pg8::cvt_pk_bf16(v0[0], v0[1]); w[bj].y = pg8::cvt_pk_bf16(v0[2], v0[3]); w[bj].z = pg8::cvt_pk_bf16(v1[0], v1[1]); w[bj].w = pg8::cvt_pk_bf16(v1[2], v1[3]); }
                    u32x4 s1, s2;
#pragma unroll
                    for (int q = 0; q < 4; ++q) { const unsigned give = hb ? w[0][q] : w[1][q]; const unsigned recv = (unsigned)__shfl_xor((int)give, 8); s1[q] = hb ? recv : w[0][q]; s2[q] = hb ? w[1][q] : recv; }
                    bf16* op = ob + (size_t)(ai * 128 + m * 16) * PW;
                    st16_wt(op, s1); st16_wt(op + 8 * PW, s2);
                    __builtin_amdgcn_sched_barrier(0); }
        } else if (u.pn < 4) {
            const int row0 = u.pm * 256 + wr * 64 + fr;
#pragma unroll
            for (int ai = 0; ai < 2; ++ai)
#pragma unroll
                for (int m = 0; m < 4; ++m) { const int row = row0 + ai * 128 + m * 16; int b, pos;
                    if (row < NTOK) { b = row >> 11; pos = CTXL + (row & 2047); } else { const int rr = row - NTOK; b = rr >> 8; pos = rr & 255; }
                    const int hd = (u.pn - 2) * 4 + wc;
#pragma unroll
                    for (int bj = 0; bj < 2; ++bj) {
                        const f32x4 v0 = acc[ai][bj][m][0] * (1.0f / (Q_SA * Q_SW)), v1 = acc[ai][bj][m][1] * (1.0f / (Q_SA * Q_SW));
                        u32x4 w; w.x = pg8::cvt_pk_bf16(v0[0], v0[1]); w.y = pg8::cvt_pk_bf16(v0[2], v0[3]); w.z = pg8::cvt_pk_bf16(v1[0], v1[1]); w.w = pg8::cvt_pk_bf16(v1[2], v1[3]);
                        st16_wt(KB + (size_t)(b * 8 + hd) * TT * 64 + (size_t)(((((pos >> 3) * 2 + bj) * 4 + fq) * 8 + (pos & 7)) * 8), w); }
                    __builtin_amdgcn_sched_barrier(0); }
        } else {
            LAS unsigned char* tp = lds + EPI_TP + (wr * 4 + wc) * (32 * EPI_TPS);
            const int lane = fq * 16 + fr, dl = lane >> 1, hb = lane & 1;
            const int hd = (u.pn - 12) * 4 + wc;
#pragma unroll
            for (int ai = 0; ai < 2; ++ai)
#pragma unroll
                for (int m = 0; m < 4; ++m) { const int rowa = u.pm * 256 + wr * 64 + ai * 128 + m * 16; int b, pos0;
                    if (rowa < NTOK) { b = rowa >> 11; pos0 = CTXL + (rowa & 2047); } else { const int rr = rowa - NTOK; b = rr >> 8; pos0 = rr & 255; }
#pragma unroll
                    for (int bj = 0; bj < 2; ++bj) {
#pragma unroll
                        for (int n = 0; n < 2; ++n)
#pragma unroll
                            for (int j = 0; j < 4; ++j) *(LAS bf16*)(tp + (8 * fq + 4 * n + j) * EPI_TPS + fr * 2) = (bf16)f2bf(acc[ai][bj][m][n][j] * (1.0f / (Q_SA * Q_SW)));
                        const u32x2 lo = *(const LAS u32x2*)(tp + dl * EPI_TPS + hb * 16), hi = *(const LAS u32x2*)(tp + dl * EPI_TPS + hb * 16 + 8);
                        st16_wt(VT + (size_t)(b * 8 + hd) * TT * 64 + (size_t)((((pos0 >> 3) + hb) * 64 + bj * 32 + dl) * 8), (u32x4){lo.x, lo.y, hi.x, hi.y}); }
                    __builtin_amdgcn_sched_barrier(0); }
        }
    }
};

template <bool BASE16> struct EpiResid {
    static constexpr bool PERM = true, WIDE = true;
    const void* base; bf16* out; const float* gate; const float* bias;
    struct Pre { f32x4 g[2][2], bs[2][2]; };
    __device__ __forceinline__ Pre pre(const pg8::Unit& u, int wr, int wc) const { const int fq = lane_id() >> 4; const int cb = u.pn * 256 + wc * 64 + 8 * fq;
        const float* gp = gate + (size_t)((u.pm * 256) >> 11) * 6144;
        Pre p;
#pragma unroll
        for (int bj = 0; bj < 2; ++bj) { const int c = cb + 32 * bj; p.g[bj][0] = *(const f32x4*)(gp + c); p.g[bj][1] = *(const f32x4*)(gp + c + 4);
            p.bs[bj][0] = (f32x4){0.f, 0.f, 0.f, 0.f}; p.bs[bj][1] = p.bs[bj][0]; if (bias) { p.bs[bj][0] = *(const f32x4*)(bias + c); p.bs[bj][1] = *(const f32x4*)(bias + c + 4); } }
        return p; }
    struct BaseW { u32x4 h[2]; f32x4 f[2][2]; };
    __device__ __forceinline__ BaseW ldbase(size_t ro, int cb) const { BaseW w;
#pragma unroll
        for (int bj = 0; bj < 2; ++bj) { const int c = cb + 32 * bj;
            if (BASE16) w.h[bj] = *(const u32x4*)((const bf16*)base + ro + c);
            else { w.f[bj][0] = *(const f32x4*)((const float*)base + ro + c); w.f[bj][1] = *(const f32x4*)((const float*)base + ro + c + 4); } }
        return w; }
    __device__ __forceinline__ void operator()(const AccT& acc, const pg8::Unit& u, int wr, int wc, int fr, int fq, const Pre& pre) const {
        { const int ln = lane_id(); fr = ln & 15; fq = ln >> 4; }
        const bool hb = fr >= 8; const int cb = u.pn * 256 + wc * 64 + 8 * fq;
        const int row0 = u.pm * 256 + wr * 64;
        BaseW nx = ldbase((size_t)(row0 + fr) * D, cb);
#pragma unroll
        for (int ai = 0; ai < 2; ++ai)
#pragma unroll
            for (int m = 0; m < 4; ++m) { const int rowg = row0 + ai * 128 + m * 16;
                const BaseW cur = nx;
                { const int gi = ai * 4 + m + 1; if (gi < 8) nx = ldbase((size_t)(row0 + (gi >> 2) * 128 + (gi & 3) * 16 + fr) * D, cb); }
                u32x4 w[2];
#pragma unroll
                for (int bj = 0; bj < 2; ++bj) {
                    constexpr float dq = 1.0f / (Q_SA * Q_SW);
                    const f32x4 v0 = acc[ai][bj][m][0] * dq + pre.bs[bj][0], v1 = acc[ai][bj][m][1] * dq + pre.bs[bj][1];
                    f32x4 x0, x1;
                    if (BASE16) { const u32x4 xb = cur.h[bj]; x0 = (f32x4){bflo(xb.x), bfhi(xb.x), bflo(xb.y), bfhi(xb.y)}; x1 = (f32x4){bflo(xb.z), bfhi(xb.z), bflo(xb.w), bfhi(xb.w)}; }
                    else { x0 = cur.f[bj][0]; x1 = cur.f[bj][1]; }
                    const f32x4 r0 = x0 + pre.g[bj][0] * v0, r1 = x1 + pre.g[bj][1] * v1;
                    w[bj].x = pg8::cvt_pk_bf16(r0[0], r0[1]); w[bj].y = pg8::cvt_pk_bf16(r0[2], r0[3]); w[bj].z = pg8::cvt_pk_bf16(r1[0], r1[1]); w[bj].w = pg8::cvt_pk_bf16(r1[2], r1[3]); }
                u32x4 s1, s2;
#pragma unroll
                for (int q = 0; q < 4; ++q) { const unsigned give = hb ? w[0][q] : w[1][q]; const unsigned recv = (unsigned)__shfl_xor((int)give, 8); s1[q] = hb ? recv : w[0][q]; s2[q] = hb ? w[1][q] : recv; }
                bf16* op = out + (size_t)(rowg + (fr & 7)) * D + cb + (hb ? 32 : 0);
                st16_wt(op, s1); st16_wt(op + 8 * D, s2);
                __builtin_amdgcn_sched_barrier(0); }
    }
};

template <int MODE> struct EpiPair {
    static constexpr bool PERM = true, WIDE = true;
    bf16* O; const float* bias; const int* tile_e;
    struct Pre { f32x4 x[2]; };
    __device__ __forceinline__ void ldbias(const pg8::Unit& u, int c0, f32x4 (&x)[2]) const { const float* bp = bias; if (MODE == 0) bp += (size_t)u.e * 2048;
        if (MODE == 0) { x[0] = *(const f32x4*)(bp + c0); x[1] = *(const f32x4*)(bp + c0 + 4); } else { x[0] = *(const f32x4*)(bp + (c0 >> 1)); x[1] = *(const f32x4*)(bp + 1024 + (c0 >> 1)); } }
    __device__ __forceinline__ Pre pre(const pg8::Unit& u, int wr, int wc) const { Pre p; ldbias(u, u.pn * 256 + wc * 64 + 8 * (lane_id() >> 4), p.x); return p; }
    __device__ __forceinline__ void operator()(const AccT& acc, const pg8::Unit& u, int wr, int wc, int fr, int fq, const Pre& pre) const {
        { const int ln = lane_id(); fr = ln & 15; fq = ln >> 4; }
        const bool hb = fr >= 8; const int cb = u.pn * 256 + wc * 64 + 8 * fq;
        unsigned st8[2][4]; u32x2 st16[2][4];
        f32x4 xb1[2];
#pragma unroll
        for (int bj = 0; bj < 2; ++bj) {
            const f32x4 xa0 = bj == 0 ? pre.x[0] : xb1[0], xa1 = bj == 0 ? pre.x[1] : xb1[1];
            float bg[4], bl[4];
            if (MODE == 0) { bg[0] = xa0[0]; bl[0] = xa0[1]; bg[1] = xa0[2]; bl[1] = xa0[3]; bg[2] = xa1[0]; bl[2] = xa1[1]; bg[3] = xa1[2]; bl[3] = xa1[3]; }
            else {
#pragma unroll
                for (int p = 0; p < 4; ++p) { bg[p] = xa0[p]; bl[p] = xa1[p]; } }
#pragma unroll
            for (int ai = 0; ai < 2; ++ai)
#pragma unroll
                for (int m = 0; m < 4; ++m) {
                    if (bj == 0 && ai == 1 && m == 0) ldbias(u, cb + 32, xb1);
                    constexpr float dq = 1.0f / (Q_SA * Q_SW);
                    const f32x4 v0 = acc[ai][bj][m][0], v1 = acc[ai][bj][m][1];
                    const float e[4] = {__builtin_fmaf(v0[0], dq, bg[0]), __builtin_fmaf(v0[2], dq, bg[1]), __builtin_fmaf(v1[0], dq, bg[2]), __builtin_fmaf(v1[2], dq, bg[3])};
                    const float o[4] = {__builtin_fmaf(v0[1], dq, bl[0]), __builtin_fmaf(v0[3], dq, bl[1]), __builtin_fmaf(v1[1], dq, bl[2]), __builtin_fmaf(v1[3], dq, bl[3])};
                    float r[4];
#pragma unroll
                    for (int p = 0; p < 4; ++p) {
                        if (MODE == 0) { const float gl = fminf(e[p], 7.0f);
                            const float q = __builtin_amdgcn_rcpf(1.0f + __builtin_amdgcn_exp2f(gl * (-1.702f * 1.44269504089f)));
                            r[p] = (gl * q) * __builtin_fmaf(__builtin_amdgcn_fmed3f(o[p], -7.0f, 7.0f), Q_SA2, Q_SA2); }
                        else r[p] = e[p] * sigmoidf_(o[p]); }
                    if (MODE == 0) { const unsigned w = pk4_fp8(r[0], r[1], r[2], r[3]);
                        if (bj == 0) st8[ai][m] = w;
                        else { const unsigned w0 = st8[ai][m], give = hb ? w0 : w, recv = (unsigned)__shfl_xor((int)give, 8);
                            unsigned char* op = (unsigned char*)O + (size_t)(u.pm * 256 + wr * 64 + ai * 128 + m * 16 + (fr & 7)) * D + (cb >> 1) + (hb ? 16 : 0);
                            *(unsigned*)op = hb ? recv : w0; *(unsigned*)(op + 8 * D) = hb ? w : recv; } }
                    else { u32x2 w; w.x = pg8::cvt_pk_bf16(r[0], r[1]); w.y = pg8::cvt_pk_bf16(r[2], r[3]);
                        if (bj == 0) st16[ai][m] = w;
                        else { const u32x2 w0 = st16[ai][m]; u32x2 s1, s2;
#pragma unroll
                            for (int q = 0; q < 2; ++q) { const unsigned give = hb ? w0[q] : w[q], recv = (unsigned)__shfl_xor((int)give, 8); s1[q] = hb ? recv : w0[q]; s2[q] = hb ? w[q] : recv; }
                            bf16* op = O + (size_t)(u.pm * 256 + wr * 64 + ai * 128 + m * 16 + (fr & 7)) * D + (cb >> 1) + (hb ? 16 : 0);
                            *(u32x2*)op = s1; *(u32x2*)(op + 8 * D) = s2; } }
                    __builtin_amdgcn_sched_barrier(0); }
        }
    }
};

struct EpiMoe2 {
    static constexpr bool PERM = true, WIDE = true;
    bf16* O; const float* bias; const int* tile_e;
    struct Pre { f32x4 bv[2][2]; };
    __device__ __forceinline__ Pre pre(const pg8::Unit& u, int wr, int wc) const { const int fq = lane_id() >> 4; const float* bp = bias + (size_t)u.e * 1024 + u.pn * 256 + wc * 64 + 8 * fq; Pre p;
#pragma unroll
        for (int bj = 0; bj < 2; ++bj) { p.bv[bj][0] = *(const f32x4*)(bp + 32 * bj); p.bv[bj][1] = *(const f32x4*)(bp + 32 * bj + 4); }
        return p; }
    __device__ __forceinline__ void operator()(const AccT& acc, const pg8::Unit& u, int wr, int wc, int fr, int fq, const Pre& pre) const {
        const int rlo = fr & 7, hb = fr >> 3, cb = u.pn * 256 + wc * 64 + 8 * fq;
        const f32x4 (&bv)[2][2] = pre.bv;
#pragma unroll
        for (int ai = 0; ai < 2; ++ai)
#pragma unroll
            for (int m = 0; m < 4; ++m) { bf16* rowp = O + (size_t)(u.pm * 256 + wr * 64 + ai * 128 + m * 16 + rlo) * D + cb + 32 * hb;
                constexpr float dq = 1.0f / (Q_SA2 * Q_SW);
                u32x4 w[2];
#pragma unroll
                for (int bj = 0; bj < 2; ++bj) { const f32x4 v0 = acc[ai][bj][m][0] * dq + bv[bj][0], v1 = acc[ai][bj][m][1] * dq + bv[bj][1];
                    w[bj].x = pg8::cvt_pk_bf16(v0[0], v0[1]); w[bj].y = pg8::cvt_pk_bf16(v0[2], v0[3]); w[bj].z = pg8::cvt_pk_bf16(v1[0], v1[1]); w[bj].w = pg8::cvt_pk_bf16(v1[2], v1[3]); }
                u32x4 s1, s2;
#pragma unroll
                for (int q = 0; q < 4; ++q) { const unsigned give = hb ? w[0][q] : w[1][q]; const unsigned recv = (unsigned)__shfl_xor((int)give, 8); s1[q] = hb ? recv : w[0][q]; s2[q] = hb ? w[1][q] : recv; }
                st16_wt(rowp, s1); st16_wt(rowp + 8 * D, s2);
                __builtin_amdgcn_sched_barrier(0); }
    }
};

__device__ __forceinline__ float xrow16_sum(float x) {
    auto s = __builtin_amdgcn_permlane16_swap(__float_as_uint(x), __float_as_uint(x), false, false);
    x = __uint_as_float(s[0]) + __uint_as_float(s[1]);
    auto t = __builtin_amdgcn_permlane32_swap(__float_as_uint(x), __float_as_uint(x), false, false);
    return __uint_as_float(t[0]) + __uint_as_float(t[1]);
}
constexpr int XLS = 392;
__device__ __forceinline__ void shift8(const bf16* pr, int pc, bool hasp, bool hasn, const float* mup, const float* mun, float (&s)[8]) {
    const u32x4 c = *(const u32x4*)(pr + pc);
    u32x4 p = (u32x4){0u, 0u, 0u, 0u}, n = (u32x4){0u, 0u, 0u, 0u};
    if (hasp) p = *(const u32x4*)(pr - PW + pc);
    if (hasn) n = *(const u32x4*)(pr + PW + pc);
    const int mi = pc - 1024;
    const f32x4 mp0 = *(const f32x4*)(mup + mi), mp1 = *(const f32x4*)(mup + mi + 4), mn0 = *(const f32x4*)(mun + mi), mn1 = *(const f32x4*)(mun + mi + 4);
#pragma unroll
    for (int q = 0; q < 4; ++q) {
        const float c0 = bflo(c[q]), c1 = bfhi(c[q]), p0 = bflo(p[q]), p1 = bfhi(p[q]), n0 = bflo(n[q]), n1 = bfhi(n[q]);
        const float a0 = q < 2 ? mp0[2 * q] : mp1[2 * q - 4], a1 = q < 2 ? mp0[2 * q + 1] : mp1[2 * q - 3];
        const float b0 = q < 2 ? mn0[2 * q] : mn1[2 * q - 4], b1 = q < 2 ? mn0[2 * q + 1] : mn1[2 * q - 3];
        s[2 * q] = c0 + a0 * (p0 - c0) + b0 * (n0 - c0); s[2 * q + 1] = c1 + a1 * (p1 - c1) + b1 * (n1 - c1);
    }
}
__device__ __forceinline__ void shift4(const bf16* pr, int pc, bool hasp, bool hasn, const float* mup, const float* mun, float (&s)[4]) {
    const u32x2 c = *(const u32x2*)(pr + pc);
    u32x2 p = (u32x2){0u, 0u}, n = (u32x2){0u, 0u};
    if (hasp) p = *(const u32x2*)(pr - PW + pc);
    if (hasn) n = *(const u32x2*)(pr + PW + pc);
    const int mi = pc - 1024;
    const f32x4 mp = *(const f32x4*)(mup + mi), mn = *(const f32x4*)(mun + mi);
#pragma unroll
    for (int q = 0; q < 2; ++q) {
        const float c0 = bflo(c[q]), c1 = bfhi(c[q]), p0 = bflo(p[q]), p1 = bfhi(p[q]), n0 = bflo(n[q]), n1 = bfhi(n[q]);
        s[2 * q] = c0 + mp[2 * q] * (p0 - c0) + mn[2 * q] * (n0 - c0); s[2 * q + 1] = c1 + mp[2 * q + 1] * (p1 - c1) + mn[2 * q + 1] * (n1 - c1);
    }
}


constexpr int SQ_STEPS = 16, SQ_NSUB = TT / SQ_STEPS, SQ_BLKB = 1840, SQ_SLOTB = 8 * SQ_BLKB, SQ_NSLOT = 6;
constexpr int SQ_RING = 0, SQ_FLAG = SQ_NSLOT * SQ_SLOTB, SQ_XL = SQ_FLAG + 64, SQ_XLS = 264, SQ_XLW = 16 * SQ_XLS * 2;
constexpr int MUK = 0, MUV = 64, MUR = 128, MUW = 192, MUA = 256, MUG = 320, MUN = 448;
constexpr int SQ_NPROD = 5;
constexpr int SQ_MU = SQ_XL + SQ_NPROD * SQ_XLW, SQ_PAR = SQ_MU + 2 * MUN * 4, SQ_WL = SQ_PAR + 5 * 64 * 4;
constexpr int WLS2 = 72, WLSG = 136;
constexpr int SQ_WLD = SQ_WL, SQ_WLI = SQ_WLD + 64 * WLS2 * 2, SQ_END = SQ_WLI + 64 * WLS2 * 2;
static_assert(SQ_END <= LDSCTL_OFF && SQ_XL % 16 == 0 && SQ_MU % 16 == 0 && SQ_WL % 16 == 0, "scan LDS map");

constexpr int BG_GROUPS = 64 * 8 * 8 + 64 * 8 * 4, BG_SUB = 16, BG_ROWS = 8;
struct BgJob { const float* src; unsigned char* dst; int N; };
__device__ __forceinline__ BgJob bg_job(ArgP a, int grp, int kbl, int lane) {
    const float* W; unsigned char* WT; int N, nb, kh;
    if (grp < 4096) { const int mi = grp >> 6; kh = (grp >> 3) & 7; nb = grp & 7; N = 2048; W = a->in[I_EW1] + (size_t)mi * 1024 * 2048; WT = a->ws + WS_EW1 + (size_t)mi * 2048 * 1024; }
    else { const int q = grp - 4096, mi = q >> 5; kh = (q >> 2) & 7; nb = q & 3; N = 1024; W = a->in[I_EW2] + (size_t)mi * 1024 * 1024; WT = a->ws + WS_EW2 + (size_t)mi * 1024 * 1024; }
    const int k0 = kh * 128 + BG_ROWS * (lane & 15), n = nb * 256 + 16 * kbl + 4 * (lane >> 4);
    BgJob j; j.src = W + (size_t)k0 * N + n; j.dst = WT + (size_t)n * 1024 + k0; j.N = N; return j;
}
__device__ __forceinline__ void bg_issue(const BgJob& j, f32x4 (&v)[BG_ROWS]) {
#pragma unroll
    for (int i = 0; i < BG_ROWS; ++i) v[i] = *(const f32x4*)(j.src + (size_t)i * j.N);
}
__device__ __forceinline__ void bg_finish(const BgJob& j, const f32x4 (&v)[BG_ROWS]) {
#pragma unroll
    for (int q = 0; q < 4; ++q) { u32x2 o;
        o.x = pk4_fp8(v[0][q] * Q_SW, v[1][q] * Q_SW, v[2][q] * Q_SW, v[3][q] * Q_SW); o.y = pk4_fp8(v[4][q] * Q_SW, v[5][q] * Q_SW, v[6][q] * Q_SW, v[7][q] * Q_SW);
        *(u32x2*)(j.dst + (size_t)q * 1024) = o; }
}

struct Raw4 { u32x2 c, p, n; };
struct Raw8 { u32x4 c, p, n; };
__device__ __forceinline__ Raw4 raw4_load(const bf16* pr, int pc, bool hasp, bool hasn) { Raw4 r; r.c = *(const u32x2*)(pr + pc); r.p = (u32x2){0u, 0u}; r.n = (u32x2){0u, 0u};
    if (hasp) r.p = *(const u32x2*)(pr - PW + pc); if (hasn) r.n = *(const u32x2*)(pr + PW + pc); return r; }
__device__ __forceinline__ Raw8 raw8_load(const bf16* pr, int pc, bool hasp, bool hasn) { Raw8 r; r.c = *(const u32x4*)(pr + pc); r.p = (u32x4){0u, 0u, 0u, 0u}; r.n = (u32x4){0u, 0u, 0u, 0u};
    if (hasp) r.p = *(const u32x4*)(pr - PW + pc); if (hasn) r.n = *(const u32x4*)(pr + PW + pc); return r; }
__device__ __forceinline__ void shift4_raw(const Raw4& r, int mi, const LAS float* MU, float (&s)[4]) {
    const f32x4 mp = *(const LAS f32x4*)(MU + mi), mn = *(const LAS f32x4*)(MU + MUN + mi);
#pragma unroll
    for (int q = 0; q < 2; ++q) { const float c0 = bflo(r.c[q]), c1 = bfhi(r.c[q]);
        s[2 * q] = c0 + mp[2 * q] * (bflo(r.p[q]) - c0) + mn[2 * q] * (bflo(r.n[q]) - c0); s[2 * q + 1] = c1 + mp[2 * q + 1] * (bfhi(r.p[q]) - c1) + mn[2 * q + 1] * (bfhi(r.n[q]) - c1); }
}
__device__ __forceinline__ void shift8_raw(const Raw8& r, int mi, const LAS float* MU, float (&s)[8]) {
    const f32x4 mp0 = *(const LAS f32x4*)(MU + mi), mp1 = *(const LAS f32x4*)(MU + mi + 4), mn0 = *(const LAS f32x4*)(MU + MUN + mi), mn1 = *(const LAS f32x4*)(MU + MUN + mi + 4);
#pragma unroll
    for (int q = 0; q < 4; ++q) { const float c0 = bflo(r.c[q]), c1 = bfhi(r.c[q]);
        const float a0 = q < 2 ? mp0[2 * q] : mp1[2 * q - 4], a1 = q < 2 ? mp0[2 * q + 1] : mp1[2 * q - 3], b0 = q < 2 ? mn0[2 * q] : mn1[2 * q - 4], b1 = q < 2 ? mn0[2 * q + 1] : mn1[2 * q - 3];
        s[2 * q] = c0 + a0 * (bflo(r.p[q]) - c0) + b0 * (bflo(r.n[q]) - c0); s[2 * q + 1] = c1 + a1 * (bfhi(r.p[q]) - c1) + b1 * (bfhi(r.n[q]) - c1); }
}

__device__ __forceinline__ void scan_produce(ArgP a, LAS unsigned char* lds, int dir, int b, int h, int sc, int lw, int lane) {
    asm volatile("" : "+v"(lane));
    unsigned char* ws = a->ws;
    const bf16* P = (const bf16*)(ws + WS_P);
    const LAS bf16* WLD = (const LAS bf16*)(lds + SQ_WLD); const LAS bf16* WLI = (const LAS bf16*)(lds + SQ_WLI); const bf16* G2H = (const bf16*)(a->ws + WS_SMALLW) + 64 * h * 128;
    const LAS float* MU = (const LAS float*)(lds + SQ_MU); const LAS float* PAR = (const LAS float*)(lds + SQ_PAR);
    LAS bf16* XL = (LAS bf16*)(lds + SQ_XL + lw * SQ_XLW);
    const int sq = sc % SQ_NSLOT; LAS unsigned char* slot = lds + SQ_RING + sq * SQ_SLOTB;
    const int s0 = sc * SQ_STEPS; const bool is_ctx = s0 < CTXL; const int L = is_ctx ? CTXL : T, rowbase = is_ctx ? NTOK + b * CTXL : b * T;
    const int tlo = dir == 0 ? (is_ctx ? s0 : s0 - CTXL) : (is_ctx ? CTXL - 16 - s0 : T - 16 - (s0 - CTXL));
    const int g = lane >> 4, n = lane & 15;
    const bool do_g = !is_ctx && ((tlo >= T / 2) == (dir != 0));
    const int t = tlo + n, sl = dir == 0 ? n : 15 - n;
    const bf16* pr = P + (size_t)(rowbase + t) * PW; const bool hp = t > 0, hn = t < L - 1;
    Raw4 rk_[4], rv_[4], rr_[4];
#pragma unroll
    for (int ct = 0; ct < 4; ++ct) { const int co = 64 * h + 16 * ct + 4 * g; rk_[ct] = raw4_load(pr, PC_KA + co, hp, hn); rv_[ct] = raw4_load(pr, PC_VA + co, hp, hn); rr_[ct] = raw4_load(pr, PC_RA + co, hp, hn); }
    {   const int tl = lane >> 2, sub = lane & 3, t1 = tlo + tl;
        const bf16* p1 = P + (size_t)(rowbase + t1) * PW; const bool hp1 = t1 > 0, hn1 = t1 < L - 1;
        Raw8 rw[2], ra[2];
#pragma unroll
        for (int q = 0; q < 2; ++q) { rw[q] = raw8_load(p1, PC_WD + 64 * dir + 16 * sub + 8 * q, hp1, hn1); ra[q] = raw8_load(p1, PC_AD + 64 * dir + 16 * sub + 8 * q, hp1, hn1); }
#pragma unroll
        for (int q = 0; q < 2; ++q) {
            float s[8]; shift8_raw(rw[q], MUW + 16 * sub + 8 * q, MU, s);
#pragma unroll
            for (int i = 0; i < 8; ++i) { const float e = __expf(2.0f * s[i]); s[i] = 1.0f - 2.0f * __builtin_amdgcn_rcpf(e + 1.0f); }
            u32x4 o; o.x = pk2(s[0], s[1]); o.y = pk2(s[2], s[3]); o.z = pk2(s[4], s[5]); o.w = pk2(s[6], s[7]);
            *(LAS u32x4*)(XL + tl * SQ_XLS + 16 * sub + 8 * q) = o;
            shift8_raw(ra[q], MUA + 16 * sub + 8 * q, MU, s);
            o.x = pk2(s[0], s[1]); o.y = pk2(s[2], s[3]); o.z = pk2(s[4], s[5]); o.w = pk2(s[6], s[7]);
            *(LAS u32x4*)(XL + tl * SQ_XLS + 64 + 16 * sub + 8 * q) = o;
        }
        if (do_g) {
            Raw8 rg[4];
#pragma unroll
            for (int q = 0; q < 4; ++q) rg[q] = raw8_load(p1, PC_GD + 32 * sub + 8 * q, hp1, hn1);
#pragma unroll
            for (int q = 0; q < 4; ++q) {
                float s[8]; shift8_raw(rg[q], MUG + 32 * sub + 8 * q, MU, s);
#pragma unroll
                for (int i = 0; i < 8; ++i) s[i] = sigmoidf_(s[i]);
                u32x4 o; o.x = pk2(s[0], s[1]); o.y = pk2(s[2], s[3]); o.z = pk2(s[4], s[5]); o.w = pk2(s[6], s[7]);
                *(LAS u32x4*)(XL + tl * SQ_XLS + 128 + 32 * sub + 8 * q) = o;
            }
        }
    }
    asm volatile("s_waitcnt lgkmcnt(0)" ::: "memory");
    __builtin_amdgcn_sched_barrier(0);
    bf16x8 gw[4][4];
    if (do_g) {
#pragma unroll
        for (int ct = 0; ct < 4; ++ct)
#pragma unroll
            for (int ks = 0; ks < 4; ++ks) gw[ct][ks] = *(const bf16x8*)(G2H + (16 * ct + n) * 128 + 32 * ks + 8 * g);
    }
    float kx[4][4], vx[4][4], rx[4][4];
    float kk2 = 0.f;
#pragma unroll
    for (int ct = 0; ct < 4; ++ct) { const int co = 64 * h + 16 * ct + 4 * g;
        shift4_raw(rk_[ct], MUK + 16 * ct + 4 * g, MU, kx[ct]); shift4_raw(rv_[ct], MUV + 16 * ct + 4 * g, MU, vx[ct]); shift4_raw(rr_[ct], MUR + 16 * ct + 4 * g, MU, rx[ct]);
        const f32x4 kkp = *(const LAS f32x4*)(PAR + 16 * ct + 4 * g);
#pragma unroll
        for (int i = 0; i < 4; ++i) { const float q = kx[ct][i] * kkp[i]; kk2 += q * q; } }
    kk2 = xrow16_sum(kk2);
    __builtin_amdgcn_sched_barrier(0);
    const float inv = __builtin_amdgcn_rcpf(fmaxf(__builtin_amdgcn_sqrtf(kk2), 1e-12f));
    float bbr = 0.f, krs = 0.f, rks = 0.f, pp_ = 0.f, qq_ = 0.f, uu_ = 0.f, zz_ = 0.f;
    const LAS bf16* xb = XL + n * SQ_XLS + 8 * g;
    const int role = sl & 1;
    LAS unsigned char* sb = slot + (sl >> 1) * SQ_BLKB;
    bf16* GB = (bf16*)(ws + WS_GB) + (size_t)(rowbase + t) * 1024;
    bf16* BN1 = (bf16*)(ws + WS_BON1) + (size_t)(rowbase + t) * 512;
#pragma unroll
    for (int ct = 0; ct < 4; ++ct) {
        const int cl = 16 * ct + 4 * g, ch0 = 64 * h + cl;
        f32x4 ag = (f32x4){0.f, 0.f, 0.f, 0.f}, adc = ag, aic = ag;
        if (do_g) {
#pragma unroll
            for (int ks = 0; ks < 4; ++ks) ag = __builtin_amdgcn_mfma_f32_16x16x32_bf16(gw[ct][ks], *(const LAS bf16x8*)(xb + 128 + 32 * ks), ag, 0, 0, 0);
        }
#pragma unroll
        for (int ks = 0; ks < 2; ++ks) {
            adc = __builtin_amdgcn_mfma_f32_16x16x32_bf16(*(const LAS bf16x8*)(WLD + (16 * ct + n) * WLS2 + 32 * ks + 8 * g), *(const LAS bf16x8*)(xb + 32 * ks), adc, 0, 0, 0);
            aic = __builtin_amdgcn_mfma_f32_16x16x32_bf16(*(const LAS bf16x8*)(WLI + (16 * ct + n) * WLS2 + 32 * ks + 8 * g), *(const LAS bf16x8*)(xb + 64 + 32 * ks), aic, 0, 0, 0); }
        const f32x4 kkp = *(const LAS f32x4*)(PAR + cl), kap = *(const LAS f32x4*)(PAR + 64 + cl), rkp = *(const LAS f32x4*)(PAR + 128 + cl);
        const f32x4 w0p = *(const LAS f32x4*)(PAR + 192 + cl), a0p = *(const LAS f32x4*)(PAR + 256 + cl);
        f32x4 aav, wv, kdv, bbv, wrv;
#pragma unroll
        for (int i = 0; i < 4; ++i) {
            aav[i] = -(kx[ct][i] * kkp[i] * inv);
            const float dec = __expf(-0.60653065971f * sigmoidf_(w0p[i] + adc[i]));
            const float av = sigmoidf_(a0p[i] + aic[i]);
            const float kd = kx[ct][i] * (1.0f + (av - 1.0f) * kap[i]);
            const float bb = -aav[i] * av;
            const float r = rx[ct][i];
            wv[i] = dec; kdv[i] = kd; bbv[i] = bb; wrv[i] = dec * r;
            bbr += bb * r; krs += kd * r; rks += r * kd * rkp[i];
        }
        {
            f32x4 wn, an, rn;
#pragma unroll
            for (int i = 0; i < 4; ++i) { wn[i] = __shfl_xor(wv[i], 1);
                an[i] = __shfl_xor(aav[i], 1);
                rn[i] = __shfl_xor(wrv[i], 1); }
#pragma unroll
            for (int i = 0; i < 4; ++i) { pp_ += bbv[i] * an[i]; qq_ += kdv[i] * an[i]; uu_ += bbv[i] * rn[i]; zz_ += kdv[i] * rn[i]; }
            *(LAS f32x4*)(sb + 256 + role * 256 + cl * 4) = (f32x4){vx[ct][0], vx[ct][1], vx[ct][2], vx[ct][3]};
#pragma unroll
            for (int i = 0; i < 4; ++i) *(LAS unsigned*)(sb + 768 + (cl + i) * 8 + role * 4) = role ? pk2(bbv[i], kdv[i]) : pk2(bbv[i] * wn[i], kdv[i] * wn[i]);
            if (role == 0) {
                *(LAS f32x4*)(sb + cl * 4) = wv * wn;
                const int po = ((ct >> 1) * 4 + g) * 16 + (ct & 1) * 8;
                u32x2 o0, o1, o2, o3; o0.x = pk2(aav[0], aav[1]); o0.y = pk2(aav[2], aav[3]); o1.x = pk2(wrv[0], wrv[1]); o1.y = pk2(wrv[2], wrv[3]);
                o2.x = pk2(wv[0] * an[0], wv[1] * an[1]); o2.y = pk2(wv[2] * an[2], wv[3] * an[3]); o3.x = pk2(wv[0] * rn[0], wv[1] * rn[1]); o3.y = pk2(wv[2] * rn[2], wv[3] * rn[3]);
                *(LAS u32x2*)(sb + 1280 + po) = o0; *(LAS u32x2*)(sb + 1408 + po) = o1; *(LAS u32x2*)(sb + 1536 + po) = o2; *(LAS u32x2*)(sb + 1664 + po) = o3;
            }
        }
        if (do_g) { u32x2 o; o.x = pk2(ag[0], ag[1]); o.y = pk2(ag[2], ag[3]); *(u32x2*)(GB + ch0) = o; }
        __builtin_amdgcn_sched_barrier(0);
    }
    bbr = xrow16_sum(bbr); krs = xrow16_sum(krs); rks = xrow16_sum(rks); pp_ = xrow16_sum(pp_); qq_ = xrow16_sum(qq_); uu_ = xrow16_sum(uu_); zz_ = xrow16_sum(zz_);
    if (g == 0) { LAS float* scp = (LAS float*)(sb + 1792);
        if (role == 0) { *(LAS f32x4*)scp = (f32x4){bbr, krs, pp_, qq_}; *(LAS f32x2*)(scp + 4) = (f32x2){uu_, zz_}; } else *(LAS f32x2*)(scp + 6) = (f32x2){bbr, krs}; }
    if (!is_ctx) {
#pragma unroll
        for (int ct = 0; ct < 4; ++ct) { const int ch0 = 64 * h + 16 * ct + 4 * g;
            u32x2 o; o.x = pk2(rks * vx[ct][0], rks * vx[ct][1]); o.y = pk2(rks * vx[ct][2], rks * vx[ct][3]);
            if (dir == 0) *(u32x2*)(GB + 512 + ch0) = o; else *(u32x2*)(BN1 + ch0) = o; } }
}

typedef short s16x4 __attribute__((ext_vector_type(4)));
__device__ __forceinline__ unsigned lds_ld_acq(LAS unsigned* p) { return __hip_atomic_load(p, __ATOMIC_ACQUIRE, __HIP_MEMORY_SCOPE_WORKGROUP); }

__device__ __forceinline__ void p4_scan(ArgP a, const Ctx& F) {
    unsigned char* ws = a->ws;
    LAS unsigned* flags = (LAS unsigned*)(F.lds + SQ_FLAG);
    for (int chr = F.vcu; chr < 256 * PROBE_R_SCAN; chr += F.G) {
        const int ch = chr & 255, dir = ch >> 7, b = (ch >> 3) & 15, h = ch & 7;
        if (F.tid < 16) flags[F.tid] = 0u;
        for (int i = F.tid; i < 2 * MUN; i += NTHR) { const int pn = i >= MUN, j = pn ? i - MUN : i;
            const int src = j < 64 ? (PC_KA - 1024) + 64 * h + j : (j < 128 ? (PC_VA - 1024) + 64 * h + (j - 64) : (j < 192 ? (PC_RA - 1024) + 64 * h + (j - 128) :
                            (j < 256 ? (PC_WD - 1024) + 64 * dir + (j - 192) : (j < 320 ? (PC_AD - 1024) + 64 * dir + (j - 256) : (PC_GD - 1024) + (j - 320)))));
            ((LAS float*)(F.lds + SQ_MU))[i] = pn ? a->in[I_MUN][src] : a->in[I_MUP][src]; }
        if (F.tid < 320) { const int q = F.tid >> 6, cc = 64 * h + (F.tid & 63);
            ((LAS float*)(F.lds + SQ_PAR))[F.tid] = q == 0 ? a->in[I_KK][cc] : (q == 1 ? a->in[I_KA][cc] : (q == 2 ? a->in[I_RK][cc] : (q == 3 ? a->in[I_W0][dir * 512 + cc] : a->in[I_A0][dir * 512 + cc]))); }
        {   const bf16* G2T = (const bf16*)(ws + WS_SMALLW); const bf16* W2T = G2T + 65536 + dir * 32768 + 64 * h * 64; const bf16* A2T = G2T + 131072 + dir * 32768 + 64 * h * 64;
            { const int row = F.tid >> 3, c8 = (F.tid & 7) * 8;
              *(LAS u32x4*)((LAS bf16*)(F.lds + SQ_WLD) + row * WLS2 + c8) = *(const u32x4*)(W2T + row * 64 + c8);
              *(LAS u32x4*)((LAS bf16*)(F.lds + SQ_WLI) + row * WLS2 + c8) = *(const u32x4*)(A2T + row * 64 + c8); }
}
        __syncthreads();
        if (F.wave >= 2 && F.wave < 2 + SQ_NPROD) {
            const int lw = F.wave - 2;
            __builtin_amdgcn_s_setprio(0);
            for (;;) {
                const int sc = __builtin_amdgcn_readfirstlane((int)__hip_atomic_fetch_add(flags + 10, 1u, __ATOMIC_RELAXED, __HIP_MEMORY_SCOPE_WORKGROUP)) >> 6;
                if (sc >= SQ_NSUB) break;
                if (sc >= SQ_NSLOT) {
                    const unsigned need = (unsigned)(sc - SQ_NSLOT + 1);
                    for (unsigned sp = 0; min(lds_ld_acq(flags + 6), lds_ld_acq(flags + 7)) < need && sp < (1u << 16); ++sp) __builtin_amdgcn_s_sleep(2);
                }
                scan_produce(a, F.lds, dir, b, h, sc, lw, F.lane);
                asm volatile("s_waitcnt lgkmcnt(0)" ::: "memory");
                if (F.lane == 0) __hip_atomic_store(flags + sc % SQ_NSLOT, (unsigned)(sc + 1), __ATOMIC_RELEASE, __HIP_MEMORY_SCOPE_WORKGROUP);
            }
        } else if (F.wave == 7) {
            __builtin_amdgcn_s_setprio(0);
            int bg_grp = (chr < F.G) ? F.vcu : BG_GROUPS, bg_k = 0;
            while (bg_grp < BG_GROUPS) {
                BgJob j0 = bg_job(a, bg_grp, bg_k, F.lane), j1 = bg_job(a, bg_grp, bg_k + 1, F.lane), j2 = bg_job(a, bg_grp, bg_k + 2, F.lane), j3 = bg_job(a, bg_grp, bg_k + 3, F.lane);
                f32x4 v0[BG_ROWS], v1[BG_ROWS], v2[BG_ROWS], v3[BG_ROWS];
                bg_issue(j0, v0); bg_issue(j1, v1); bg_issue(j2, v2); bg_issue(j3, v3);
                bg_finish(j0, v0); bg_finish(j1, v1); bg_finish(j2, v2); bg_finish(j3, v3);
                bg_k += 4; if (bg_k == BG_SUB) { bg_k = 0; bg_grp += F.G; }
            }
        } else {
            __builtin_amdgcn_s_setprio(3);
            unsigned* Y = (unsigned*)(ws + WS_Y) + (((size_t)dir * NTOK + (size_t)b * T) >> 1) * 512 + h * 64;
            const int riA = 32 * F.wave + (F.lane & 15), riB = riA + 16, g = F.lane >> 4;
            const int aoffb = (F.lane & 3) * 128 + g * 16;
            const LAS unsigned char* ZR = (const LAS unsigned char*)(flags + 12);
            f32x4 stA[4], stB[4];
#pragma unroll
            for (int i = 0; i < 4; ++i) { stA[i] = (f32x4){0.f, 0.f, 0.f, 0.f}; stB[i] = stA[i]; }
#pragma unroll 1
            for (int sc = 0; sc < SQ_NSUB; ++sc) {
                const int sq = sc % SQ_NSLOT;
                for (unsigned sp = 0; lds_ld_acq(flags + sq) != (unsigned)(sc + 1) && sp < (1u << 16); ++sp) __builtin_amdgcn_s_sleep(1);
                const LAS unsigned char* DB = (const LAS unsigned char*)(F.lds + SQ_RING + sq * SQ_SLOTB);
                const int s0 = sc * SQ_STEPS; const bool is_ctx = s0 < CTXL;
                const int t0 = dir == 0 ? s0 - CTXL : T - 1 - (s0 - CTXL); const int tstep = dir == 0 ? 1 : -1;
#define SCAN_LD(bk_, X) const LAS unsigned char* sp##X = DB + (bk_) * SQ_BLKB; \
                    const f32x4 w0##X = *(const LAS f32x4*)(sp##X + (0 + 4 * g) * 4), w1##X = *(const LAS f32x4*)(sp##X + (16 + 4 * g) * 4), w2##X = *(const LAS f32x4*)(sp##X + (32 + 4 * g) * 4), w3##X = *(const LAS f32x4*)(sp##X + (48 + 4 * g) * 4); \
                    const float vaA##X = *(const LAS float*)(sp##X + 256 + riA * 4), vbA##X = *(const LAS float*)(sp##X + 512 + riA * 4), vaB##X = *(const LAS float*)(sp##X + 256 + riB * 4), vbB##X = *(const LAS float*)(sp##X + 512 + riB * 4); \
                    const f32x4 sA##X = *(const LAS f32x4*)(sp##X + 1792), sB##X = *(const LAS f32x4*)(sp##X + 1808); \
                    const bf16x8 a0##X = *(const LAS bf16x8*)(sp##X + 1280 + aoffb), a1##X = *(const LAS bf16x8*)(sp##X + 1344 + aoffb); \
                    const u32x2 q0##X = *(const LAS u32x2*)(g > 1 ? ZR : sp##X + 768 + (0 + (F.lane & 15)) * 8), q1##X = *(const LAS u32x2*)(g > 1 ? ZR : sp##X + 768 + (16 + (F.lane & 15)) * 8), \
                                q2##X = *(const LAS u32x2*)(g > 1 ? ZR : sp##X + 768 + (32 + (F.lane & 15)) * 8), q3##X = *(const LAS u32x2*)(g > 1 ? ZR : sp##X + 768 + (48 + (F.lane & 15)) * 8)
#define SCAN_ROW(bk_, X, st, va_, vb_, ri_) do { \
                    u32x4 b0, b1; b0.x = pg8::cvt_pk_bf16(st[0][0], st[0][1]); b0.y = pg8::cvt_pk_bf16(st[0][2], st[0][3]); b0.z = pg8::cvt_pk_bf16(st[1][0], st[1][1]); b0.w = pg8::cvt_pk_bf16(st[1][2], st[1][3]); \
                    b1.x = pg8::cvt_pk_bf16(st[2][0], st[2][1]); b1.y = pg8::cvt_pk_bf16(st[2][2], st[2][3]); b1.z = pg8::cvt_pk_bf16(st[3][0], st[3][1]); b1.w = pg8::cvt_pk_bf16(st[3][2], st[3][3]); \
                    f32x4 dd = (f32x4){0.f, 0.f, 0.f, 0.f}; \
                    dd = __builtin_amdgcn_mfma_f32_16x16x32_bf16(a0##X, __builtin_bit_cast(bf16x8, b0), dd, 0, 0, 0); \
                    dd = __builtin_amdgcn_mfma_f32_16x16x32_bf16(a1##X, __builtin_bit_cast(bf16x8, b1), dd, 0, 0, 0); \
                    st[0] *= w0##X; st[1] *= w1##X; st[2] *= w2##X; st[3] *= w3##X; \
                    const float sa0 = dd[0]; \
                    const float sa1 = dd[2] + sa0 * sA##X[2] + va_ * sA##X[3]; \
                    float y0 = dd[1] + sa0 * sA##X[0] + va_ * sA##X[1]; \
                    float y1 = dd[3] + sa0 * sB##X[0] + va_ * sB##X[1] + sa1 * sB##X[2] + vb_ * sB##X[3]; \
                    const unsigned hA = pg8::cvt_pk_bf16(sa0, va_), hB = pg8::cvt_pk_bf16(sa1, vb_); \
                    const unsigned lA = pg8::cvt_pk_bf16(sa0 - __uint_as_float(hA << 16), va_ - __uint_as_float(hA & 0xffff0000u)), lB = pg8::cvt_pk_bf16(sa1 - __uint_as_float(hB << 16), vb_ - __uint_as_float(hB & 0xffff0000u)); \
                    u32x2 rb_; rb_.x = g == 0 ? hA : lA; rb_.y = g == 0 ? hB : lB;        \
                    const s16x4 rbv = __builtin_bit_cast(s16x4, rb_); \
                    st[0] = __builtin_amdgcn_mfma_f32_16x16x16bf16_1k(__builtin_bit_cast(s16x4, q0##X), rbv, st[0], 0, 0, 0); \
                    st[1] = __builtin_amdgcn_mfma_f32_16x16x16bf16_1k(__builtin_bit_cast(s16x4, q1##X), rbv, st[1], 0, 0, 0); \
                    st[2] = __builtin_amdgcn_mfma_f32_16x16x16bf16_1k(__builtin_bit_cast(s16x4, q2##X), rbv, st[2], 0, 0, 0); \
                    st[3] = __builtin_amdgcn_mfma_f32_16x16x16bf16_1k(__builtin_bit_cast(s16x4, q3##X), rbv, st[3], 0, 0, 0); \
                    asm volatile("" : "+v"(y0), "+v"(y1)); \
                    if (!is_ctx && F.lane < 16) Y[(size_t)(dir == 0 ? (t0 >> 1) + (bk_) : ((t0 - 1) >> 1) - (bk_)) * 512 + ri_] = pg8::cvt_pk_bf16(y0, y1); } while (0)
#define SCAN_DO(bk_, X) do { SCAN_ROW(bk_, X, stA, vaA##X, vbA##X, riA); SCAN_ROW(bk_, X, stB, vaB##X, vbB##X, riB); } while (0)
#pragma unroll 1
                for (int bk = 0; bk < 8; bk += 4) {
                    SCAN_LD(bk, A); SCAN_LD(bk + 1, B);
                    SCAN_DO(bk, A);
                    SCAN_LD(bk + 2, C);
                    SCAN_DO(bk + 1, B);
                    SCAN_LD(bk + 3, D);
                    SCAN_DO(bk + 2, C);
                    SCAN_DO(bk + 3, D);
                }
#undef SCAN_LD
#undef SCAN_ROW
#undef SCAN_DO
                asm volatile("s_waitcnt lgkmcnt(0)" ::: "memory");
                if (F.lane == 0) __hip_atomic_store(flags + 6 + F.wave, (unsigned)(sc + 1), __ATOMIC_RELEASE, __HIP_MEMORY_SCOPE_WORKGROUP);
            }
            __builtin_amdgcn_s_setprio(0);
        }
        __syncthreads();
    }
}


__device__ __forceinline__ float xrow16_max(float x) {
    auto s = __builtin_amdgcn_permlane16_swap(__float_as_uint(x), __float_as_uint(x), false, false);
    x = fmaxf(__uint_as_float(s[0]), __uint_as_float(s[1]));
    auto t = __builtin_amdgcn_permlane32_swap(__float_as_uint(x), __float_as_uint(x), false, false);
    return fmaxf(__uint_as_float(t[0]), __uint_as_float(t[1]));
}
constexpr int NA_RP = 0, NA_KC = 16384, NA_KCS = 72, NA_VC = NA_KC + 256 * NA_KCS * 2, NA_VCS = 264, NA_END = NA_VC + 64 * NA_VCS * 2;
static_assert(NA_END <= LDSCTL_OFF, "natten LDS map");
__device__ __forceinline__ void p5_natten(ArgP a, const Ctx& F) {
    const bf16* P = (const bf16*)(a->ws + WS_P); const bf16* VT = (const bf16*)(a->ws + WS_VT); const bf16* KB = (const bf16*)(a->ws + WS_KB); bf16* O = (bf16*)(a->ws + WS_H);
    LAS float* RP = (LAS float*)(F.lds + NA_RP);
    LAS bf16* KC = (LAS bf16*)(F.lds + NA_KC); LAS bf16* VC = (LAS bf16*)(F.lds + NA_VC);
    {   float rv[8];
#pragma unroll
        for (int q = 0; q < 8; ++q) { const int i = F.tid + NTHR * q; rv[q] = i < 8 * 15 * 31 ? a->in[I_RPB][i] : 0.f; }
#pragma unroll
        for (int q = 0; q < 8; ++q) { const int i = F.tid + NTHR * q; if (i < 8 * 15 * 31) RP[i] = rv[q]; } }
    const int g = F.lane >> 4, n = F.lane & 15;
    for (int wir = F.vcu; wir < 256 * PROBE_R_NA; wir += F.G) {
        const int wi = wir & 255, bh = wi >> 1, half = wi & 1, b = bh >> 3, h = bh & 7;
        __syncthreads();
        const bf16* KBh = KB + (size_t)(b * 8 + h) * TT * 64; const bf16* VTh = VT + (size_t)(b * 8 + h) * TT * 64;
#pragma unroll
        for (int k = 0; k < 4; ++k) { const int idx = F.tid + NTHR * k;
            { const int r8 = idx & 7, dg = (idx >> 3) & 7, blk = idx >> 6; *(LAS u32x4*)(KC + (blk * 8 + r8) * NA_KCS + dg * 8) = *(const u32x4*)(KBh + (size_t)idx * 8); }
            { const int dim = idx & 63, blk = idx >> 6; *(LAS u32x4*)(VC + dim * NA_VCS + blk * 8) = *(const u32x4*)(VTh + (size_t)idx * 8); } }
        __syncthreads();
        bf16x8 q0n, q1n, kfn[16];
        {   const int r = half * 16 + F.wave * 2, r_start = min(max(r - 4, 0), 24);
            const bf16* qp = P + (size_t)(b * T + r * 64 + n) * PW + 64 * h + 8 * g; q0n = *(const bf16x8*)qp; q1n = *(const bf16x8*)(qp + 32);
            const bf16* kb = KBh + (size_t)(((((CTXL + r_start * 64) >> 3) + (n >> 3)) * 64 + g * 8 + (n & 7)) * 8);
#pragma unroll
            for (int t = 0; t < 8; ++t) { const int ro = ((t >> 1) * 8 + (t & 1) * 2) * 512; kfn[2 * t] = *(const bf16x8*)(kb + ro); kfn[2 * t + 1] = *(const bf16x8*)(kb + ro + 256); } }
#pragma unroll 1
        for (int t8 = 0; t8 < 8; ++t8) {
            const int r = half * 16 + F.wave * 2 + (t8 >> 2), qt = t8 & 3;
            const int r_start = min(max(r - 4, 0), 24), wlo = qt == 0 ? 0 : (qt == 1 ? 8 : (qt == 2 ? 24 : 32));
            const int c = 16 * qt + n, c_start = min(max(c - 8, 0), 48);
            const bf16x8 q0 = q0n, q1 = q1n;
            const bf16* kb = KBh + (size_t)(((((CTXL + r_start * 64 + wlo) >> 3) + (n >> 3)) * 64 + g * 8 + (n & 7)) * 8);
            bf16x8 kf[16];
#pragma unroll
            for (int t = 0; t < 16; ++t) kf[t] = kfn[t];
            __builtin_amdgcn_sched_barrier(0);
            float mx, sum; f32x4 o[4];
            {   float s[16][4];
#pragma unroll
                for (int t = 0; t < 16; ++t) { const LAS bf16* kp = KC + (16 * t + n) * NA_KCS + 8 * g;
                    f32x4 acc = (f32x4){0.f, 0.f, 0.f, 0.f};
                    acc = __builtin_amdgcn_mfma_f32_16x16x32_bf16(*(const LAS bf16x8*)kp, q0, acc, 0, 0, 0);
                    acc = __builtin_amdgcn_mfma_f32_16x16x32_bf16(*(const LAS bf16x8*)(kp + 32), q1, acc, 0, 0, 0);
#pragma unroll
                    for (int i = 0; i < 4; ++i) s[t][i] = acc[i]; }
                mx = -INFINITY;
#pragma unroll
                for (int t = 0; t < 16; ++t)
#pragma unroll
                    for (int i = 0; i < 4; ++i) mx = fmaxf(mx, s[t][i]);
                mx = xrow16_max(mx);
                sum = 0.f;
#pragma unroll
                for (int dt = 0; dt < 4; ++dt) o[dt] = (f32x4){0.f, 0.f, 0.f, 0.f};
#pragma unroll
                for (int pp = 0; pp < 8; ++pp) {
                    float e[8];
#pragma unroll
                    for (int i = 0; i < 4; ++i) { e[i] = __expf(s[2 * pp][i] - mx); e[4 + i] = __expf(s[2 * pp + 1][i] - mx); }
#pragma unroll
                    for (int i = 0; i < 8; ++i) sum += e[i];
                    u32x4 w; w.x = pk2(e[0], e[1]); w.y = pk2(e[2], e[3]); w.z = pk2(e[4], e[5]); w.w = pk2(e[6], e[7]);
                    const bf16x8 pf = __builtin_bit_cast(bf16x8, w);
#pragma unroll
                    for (int dt = 0; dt < 4; ++dt) { const LAS bf16* vp = VC + (16 * dt + n) * NA_VCS + 32 * pp + 4 * g;
                        const u32x2 lo = *(const LAS u32x2*)vp, hi = *(const LAS u32x2*)(vp + 16);
                        const u32x4 vv = (u32x4){lo.x, lo.y, hi.x, hi.y};
                        o[dt] = __builtin_amdgcn_mfma_f32_16x16x32_bf16(__builtin_bit_cast(bf16x8, vv), pf, o[dt], 0, 0, 0); }
                }
                sum = xrow16_sum(sum);
            }
            __builtin_amdgcn_sched_barrier(0);
            float s[16][4];
#pragma unroll
            for (int t = 0; t < 8; ++t) {
                f32x4 acc = (f32x4){0.f, 0.f, 0.f, 0.f};
                acc = __builtin_amdgcn_mfma_f32_16x16x32_bf16(kf[2 * t], q0, acc, 0, 0, 0);
                acc = __builtin_amdgcn_mfma_f32_16x16x32_bf16(kf[2 * t + 1], q1, acc, 0, 0, 0);
#pragma unroll
                for (int i = 0; i < 4; ++i) s[t][i] = acc[i]; }
            __builtin_amdgcn_sched_barrier(0);
#pragma unroll
            for (int t8b = 0; t8b < 8; ++t8b) { const int t = 8 + t8b; const int ro = ((t >> 1) * 8 + (t & 1) * 2) * 512; kf[2 * t8b] = *(const bf16x8*)(kb + ro); kf[2 * t8b + 1] = *(const bf16x8*)(kb + ro + 256); }
            const bf16* vb = VT + (size_t)(b * 8 + h) * TT * 64 + (size_t)(((((CTXL + r_start * 64 + wlo) >> 3) + (g >> 1)) * 64 + n) * 8 + 4 * (g & 1));
            constexpr int SDT = 8, SPP = 8 * 64 * 8, SHI = 2 * 64 * 8;
            u32x2 vlo[16], vhi[16];
#pragma unroll
            for (int pp = 0; pp < 4; ++pp)
#pragma unroll
                for (int dt = 0; dt < 4; ++dt) { const bf16* vp = vb + (size_t)(16 * dt) * SDT + pp * SPP; vlo[pp * 4 + dt] = *(const u32x2*)vp; vhi[pp * 4 + dt] = *(const u32x2*)(vp + SHI); }
            __builtin_amdgcn_sched_barrier(0);
#pragma unroll
            for (int t8b = 0; t8b < 8; ++t8b) { const int t = 8 + t8b;
                f32x4 acc = (f32x4){0.f, 0.f, 0.f, 0.f};
                acc = __builtin_amdgcn_mfma_f32_16x16x32_bf16(kf[2 * t8b], q0, acc, 0, 0, 0);
                acc = __builtin_amdgcn_mfma_f32_16x16x32_bf16(kf[2 * t8b + 1], q1, acc, 0, 0, 0);
#pragma unroll
                for (int i = 0; i < 4; ++i) s[t][i] = acc[i]; }
            __builtin_amdgcn_sched_barrier(0);
#pragma unroll
            for (int t = 0; t < 16; ++t) { const LAS float* rp = RP + h * 465 + (r_start + (t >> 1) - r + 7) * 31;
#pragma unroll
                for (int i = 0; i < 4; ++i) { const int kc = wlo + 16 * (t & 1) + 4 * g + i; const bool ok = (kc >= c_start) && (kc < c_start + 16);
                    const int dc = min(max(kc - c + 15, 0), 30);
                    s[t][i] = ok ? s[t][i] + rp[dc] : -INFINITY; } }
            float ml = -INFINITY;
#pragma unroll
            for (int t = 0; t < 16; ++t)
#pragma unroll
                for (int i = 0; i < 4; ++i) ml = fmaxf(ml, s[t][i]);
            ml = xrow16_max(ml);
            const float m = fmaxf(mx, ml), fc = __expf(mx - m);
            float suml = 0.f;
#pragma unroll
            for (int dt = 0; dt < 4; ++dt) o[dt] *= fc;
            bf16x8 pf[8];
#pragma unroll
            for (int pp = 0; pp < 8; ++pp) {
                float e[8];
#pragma unroll
                for (int i = 0; i < 4; ++i) { e[i] = __expf(s[2 * pp][i] - m); e[4 + i] = __expf(s[2 * pp + 1][i] - m); }
#pragma unroll
                for (int i = 0; i < 8; ++i) suml += e[i];
                u32x4 w; w.x = pk2(e[0], e[1]); w.y = pk2(e[2], e[3]); w.z = pk2(e[4], e[5]); w.w = pk2(e[6], e[7]);
                pf[pp] = __builtin_bit_cast(bf16x8, w);
            }
            suml = xrow16_sum(suml);
#pragma unroll
            for (int pp = 0; pp < 4; ++pp)
#pragma unroll
                for (int dt = 0; dt < 4; ++dt) { const u32x4 w = (u32x4){vlo[pp * 4 + dt].x, vlo[pp * 4 + dt].y, vhi[pp * 4 + dt].x, vhi[pp * 4 + dt].y};
                    o[dt] = __builtin_amdgcn_mfma_f32_16x16x32_bf16(__builtin_bit_cast(bf16x8, w), pf[pp], o[dt], 0, 0, 0); }
#pragma unroll
            for (int pp = 4; pp < 8; ++pp)
#pragma unroll
                for (int dt = 0; dt < 4; ++dt) { const bf16* vp = vb + (size_t)(16 * dt) * SDT + pp * SPP; vlo[(pp - 4) * 4 + dt] = *(const u32x2*)vp; vhi[(pp - 4) * 4 + dt] = *(const u32x2*)(vp + SHI); }
            {   const int t9 = t8 < 7 ? t8 + 1 : 7, r9 = half * 16 + F.wave * 2 + (t9 >> 2), q9 = t9 & 3, rs9 = min(max(r9 - 4, 0), 24), wl9 = q9 == 0 ? 0 : (q9 == 1 ? 8 : (q9 == 2 ? 24 : 32));
                const bf16* qp = P + (size_t)(b * T + r9 * 64 + 16 * q9 + n) * PW + 64 * h + 8 * g; q0n = *(const bf16x8*)qp; q1n = *(const bf16x8*)(qp + 32);
                const bf16* kb9 = KBh + (size_t)(((((CTXL + rs9 * 64 + wl9) >> 3) + (n >> 3)) * 64 + g * 8 + (n & 7)) * 8);
#pragma unroll
                for (int t = 0; t < 8; ++t) { const int ro = ((t >> 1) * 8 + (t & 1) * 2) * 512; kfn[2 * t] = *(const bf16x8*)(kb9 + ro); kfn[2 * t + 1] = *(const bf16x8*)(kb9 + ro + 256); } }
#pragma unroll
            for (int pp = 4; pp < 8; ++pp)
#pragma unroll
                for (int dt = 0; dt < 4; ++dt) { const u32x4 w = (u32x4){vlo[(pp - 4) * 4 + dt].x, vlo[(pp - 4) * 4 + dt].y, vhi[(pp - 4) * 4 + dt].x, vhi[(pp - 4) * 4 + dt].y};
                    o[dt] = __builtin_amdgcn_mfma_f32_16x16x32_bf16(__builtin_bit_cast(bf16x8, w), pf[pp], o[dt], 0, 0, 0); }
            const float inv = __builtin_amdgcn_rcpf(sum * fc + suml);
            unsigned char* op = (unsigned char*)O + (size_t)(b * T + r * 64 + c) * D + 512 + 64 * h + 4 * g;
            const float inq = inv * Q_SA;
#pragma unroll
            for (int dt = 0; dt < 4; ++dt) *(unsigned*)(op + 16 * dt) = pk4_fp8(o[dt][0] * inq, o[dt][1] * inq, o[dt][2] * inq, o[dt][3] * inq);
        }
    }
    __syncthreads();
}

__device__ __forceinline__ void p6_post(ArgP a, const Ctx& F) {
    const unsigned* Y0 = (const unsigned*)(a->ws + WS_Y); const unsigned* Y1 = Y0 + (size_t)(NTOK / 2) * 512;
    const bf16* GB = (const bf16*)(a->ws + WS_GB); const bf16* BN1 = (const bf16*)(a->ws + WS_BON1); bf16* O = (bf16*)(a->ws + WS_H);
    const int gw = F.vcu * NWAVES + F.wave, NGW = F.G * NWAVES, ch0 = 8 * F.lane;
    const f32x4 lg0 = *(const f32x4*)(a->in[I_LNXG] + ch0), lg1 = *(const f32x4*)(a->in[I_LNXG] + ch0 + 4), lb0 = *(const f32x4*)(a->in[I_LNXB] + ch0), lb1 = *(const f32x4*)(a->in[I_LNXB] + ch0 + 4);
    for (int pr = gw; pr < (NTOK / 2) * PROBE_R_POST; pr += NGW) { const int pp = pr & (NTOK / 2 - 1);
        const u32x4 d0 = *(const u32x4*)(Y0 + (size_t)pp * 512 + ch0), d1 = *(const u32x4*)(Y0 + (size_t)pp * 512 + ch0 + 4), e0 = *(const u32x4*)(Y1 + (size_t)pp * 512 + ch0), e1 = *(const u32x4*)(Y1 + (size_t)pp * 512 + ch0 + 4);
        u32x4 ggq[2], bnq[2], b1q[2];
#pragma unroll
        for (int q = 0; q < 2; ++q) { const int tok = 2 * pp + q; ggq[q] = *(const u32x4*)(GB + (size_t)tok * 1024 + ch0); bnq[q] = *(const u32x4*)(GB + (size_t)tok * 1024 + 512 + ch0); b1q[q] = *(const u32x4*)(BN1 + (size_t)tok * 512 + ch0); }
#pragma unroll
      for (int q = 0; q < 2; ++q) { const int tok = 2 * pp + q;
        f32x4 ya, yb;
#pragma unroll
        for (int i = 0; i < 4; ++i) { ya[i] = q == 0 ? bflo(d0[i]) + bfhi(e0[i]) : bfhi(d0[i]) + bflo(e0[i]); yb[i] = q == 0 ? bflo(d1[i]) + bfhi(e1[i]) : bfhi(d1[i]) + bflo(e1[i]); }
        const u32x4 gg = ggq[q], bn = bnq[q], b1 = b1q[q];
        float sm = (ya.x + ya.y) + (ya.z + ya.w) + (yb.x + yb.y) + (yb.z + yb.w);
        sm += __shfl_xor(sm, 1); sm += __shfl_xor(sm, 2); sm += __shfl_xor(sm, 4);
        const float mu = sm * (1.0f / 64.0f);
        ya -= mu; yb -= mu;
        float sq = (ya.x * ya.x + ya.y * ya.y) + (ya.z * ya.z + ya.w * ya.w) + (yb.x * yb.x + yb.y * yb.y) + (yb.z * yb.z + yb.w * yb.w);
        sq += __shfl_xor(sq, 1); sq += __shfl_xor(sq, 2); sq += __shfl_xor(sq, 4);
        const float rs = __frsqrt_rn(sq * (1.0f / 64.0f) + 64e-5f);
        float r[8];
        r[0] = (ya.x * rs * lg0.x + lb0.x + bflo(bn.x) + bflo(b1.x)) * bflo(gg.x); r[1] = (ya.y * rs * lg0.y + lb0.y + bfhi(bn.x) + bfhi(b1.x)) * bfhi(gg.x);
        r[2] = (ya.z * rs * lg0.z + lb0.z + bflo(bn.y) + bflo(b1.y)) * bflo(gg.y); r[3] = (ya.w * rs * lg0.w + lb0.w + bfhi(bn.y) + bfhi(b1.y)) * bfhi(gg.y);
        r[4] = (yb.x * rs * lg1.x + lb1.x + bflo(bn.z) + bflo(b1.z)) * bflo(gg.z); r[5] = (yb.y * rs * lg1.y + lb1.y + bfhi(bn.z) + bfhi(b1.z)) * bfhi(gg.z);
        r[6] = (yb.z * rs * lg1.z + lb1.z + bflo(bn.w) + bflo(b1.w)) * bflo(gg.w); r[7] = (yb.w * rs * lg1.w + lb1.w + bfhi(bn.w) + bfhi(b1.w)) * bfhi(gg.w);
        u32x2 w; w.x = pk4_fp8(r[0] * Q_SA, r[1] * Q_SA, r[2] * Q_SA, r[3] * Q_SA); w.y = pk4_fp8(r[4] * Q_SA, r[5] * Q_SA, r[6] * Q_SA, r[7] * Q_SA);
        *(u32x2*)((unsigned char*)O + (size_t)tok * D + ch0) = w;
      }
    }
}

constexpr int RW_S = 1028;
__device__ __forceinline__ unsigned rt_key(float v, int e) { const unsigned u = __float_as_uint(v); const unsigned s = (u & 0x80000000u) ? ~u : (u | 0x80000000u); return (s & ~31u) | (unsigned)(31 - e); }
__device__ __forceinline__ float rt_val(unsigned k) { const unsigned s = k & ~31u; return __uint_as_float((s & 0x80000000u) ? (s & 0x7fffffffu) : ~s); }
__device__ __forceinline__ void p8_router(ArgP a, const Ctx& F, int l) {
    unsigned char* ws = a->ws;
    const bf16* X1 = (const bf16*)(ws + WS_X1); bf16* H = (bf16*)(ws + WS_H);
    const float* mod = (const float*)(ws + WS_MOD) + (size_t)l * 16 * 6144;
    const float* rwt = (const float*)(ws + WS_SMALLW + 393216) + (size_t)l * 32 * 1024;
    int* cnt = (int*)(ws + RT_CNT); int* toke = (int*)(ws + RT_TOKE); int* rank = (int*)(ws + RT_RANK); float* gate = (float*)(ws + RT_GATE);
    LAS float* RW = (LAS float*)F.lds; LAS float* GS = RW + 32 * RW_S; LAS float* C0 = GS + 1024; LAS int* hist = (LAS int*)(F.lds + LDSCTL_OFF + 1024);
    {   f32x4 rv[16];
#pragma unroll
        for (int q = 0; q < 16; ++q) rv[q] = ((const f32x4*)rwt)[F.tid + NTHR * q];
#pragma unroll
        for (int q = 0; q < 16; ++q) { const int i = F.tid + NTHR * q, e = i >> 8, c = i & 255; *(LAS f32x4*)(RW + e * RW_S + 4 * c) = rv[q]; } }
    if (F.tid < 32) hist[F.tid] = 0;
    const int g = F.lane >> 4, mn = F.lane & 15;
    for (int chunkr = F.vcu; chunkr < NCHUNK * PROBE_R_ROUTER; chunkr += F.G) {
        const int chunk = chunkr & (NCHUNK - 1), b = chunk >> 4;
        const float* mb = mod + (size_t)b * 6144;
        __syncthreads();
        for (int k = F.tid; k < 1024; k += NTHR) GS[k] = a->in[I_NFFNG][l * 1024 + k] * (1.0f + mb[4096 + k]);
        {   const int e = F.tid >> 4, part = F.tid & 15; float s = 0.f;
            f32x4 shv[16];
#pragma unroll
            for (int i = 0; i < 16; ++i) shv[i] = *(const f32x4*)(mb + 3072 + part * 64 + 4 * i);
#pragma unroll
            for (int i = 0; i < 16; ++i) { const f32x4 w = *(const LAS f32x4*)(RW + e * RW_S + part * 64 + 4 * i), sh = shv[i]; s += (w.x * sh.x + w.y * sh.y) + (w.z * sh.z + w.w * sh.w); }
            s += __shfl_xor(s, 1); s += __shfl_xor(s, 2); s += __shfl_xor(s, 4); s += __shfl_xor(s, 8);
            if (part == 0) C0[e] = s + a->in[I_RB][l * 32 + e]; }
        __syncthreads();
        const int row0 = chunk * CHUNK_ROWS + F.wave * 16;
        f32x4 acc0 = (f32x4){0.f, 0.f, 0.f, 0.f}, acc1 = acc0; float ss = 0.f;
        const bf16* xp = X1 + (size_t)(row0 + mn) * D + 4 * g;
#pragma unroll 1
        for (int j0 = 0; j0 < 64; j0 += 32) {
            u32x2 xq[32];
#pragma unroll
            for (int j = 0; j < 32; ++j) xq[j] = *(const u32x2*)(xp + 16 * (j0 + j));
#pragma unroll
            for (int j = 0; j < 32; ++j) { const int jj = j0 + j; const u32x2 xb = xq[j];
                const f32x4 gs = *(const LAS f32x4*)(GS + 16 * jj + 4 * g), w0 = *(const LAS f32x4*)(RW + mn * RW_S + 16 * jj + 4 * g), w1 = *(const LAS f32x4*)(RW + (16 + mn) * RW_S + 16 * jj + 4 * g);
                const f32x4 x = (f32x4){bflo(xb.x), bfhi(xb.x), bflo(xb.y), bfhi(xb.y)};
                ss += (x.x * x.x + x.y * x.y) + (x.z * x.z + x.w * x.w);
                const f32x4 xs = x * gs;
#pragma unroll
                for (int i = 0; i < 4; ++i) { acc0 = __builtin_amdgcn_mfma_f32_16x16x4f32(xs[i], w0[i], acc0, 0, 0, 0); acc1 = __builtin_amdgcn_mfma_f32_16x16x4f32(xs[i], w1[i], acc1, 0, 0, 0); }
                if ((j & 3) == 3) __builtin_amdgcn_sched_barrier(0);
            }
        }
        ss = xrow16_sum(ss);
        const float rstd_m = __frsqrt_rn(ss * (1.0f / D) + 1e-6f);
        const float c0a = C0[mn], c0b = C0[16 + mn];
        unsigned win[4][4];
#pragma unroll
        for (int i = 0; i < 4; ++i) {
            const float rs = __shfl(rstd_m, 4 * g + i);
            unsigned k0 = rt_key(rs * acc0[i] + c0a, mn), k1 = rt_key(rs * acc1[i] + c0b, 16 + mn);
#pragma unroll
            for (int r = 0; r < 4; ++r) {
                unsigned c = max(k0, k1);
                c = max(c, (unsigned)__shfl_xor((int)c, 1)); c = max(c, (unsigned)__shfl_xor((int)c, 2)); c = max(c, (unsigned)__shfl_xor((int)c, 4)); c = max(c, (unsigned)__shfl_xor((int)c, 8));
                win[i][r] = c; k0 = (k0 == c) ? 0u : k0; k1 = (k1 == c) ? 0u : k1;
            }
        }
        {
            const int ti = mn >> 2, kk = mn & 3;
            unsigned w4[4];
#pragma unroll
            for (int r = 0; r < 4; ++r) w4[r] = ti == 0 ? win[0][r] : (ti == 1 ? win[1][r] : (ti == 2 ? win[2][r] : win[3][r]));
            const float v0 = rt_val(w4[0]);
            const float e1 = __expf(rt_val(w4[1]) - v0), e2 = __expf(rt_val(w4[2]) - v0), e3 = __expf(rt_val(w4[3]) - v0);
            const float inv = __builtin_amdgcn_rcpf(1.0f + e1 + e2 + e3);
            const unsigned wk = kk == 0 ? w4[0] : (kk == 1 ? w4[1] : (kk == 2 ? w4[2] : w4[3]));
            const int e = 31 - (int)(wk & 31u);
            const float gv = (kk == 0 ? 1.0f : (kk == 1 ? e1 : (kk == 2 ? e2 : e3))) * inv;
            const int rk = __hip_atomic_fetch_add(&hist[e], 1, __ATOMIC_RELAXED, __HIP_MEMORY_SCOPE_WORKGROUP);
            const int pi = (row0 + 4 * g + ti) * 4 + kk;
            toke[pi] = e; rank[pi] = rk; gate[pi] = gv;
        }
#pragma unroll 1
        for (int r8 = 0; r8 < 16; r8 += 8) {
            u32x2 xr[8][4];
#pragma unroll
            for (int q = 0; q < 8; ++q)
#pragma unroll
                for (int j = 0; j < 4; ++j) xr[q][j] = ((const u32x2*)(X1 + (size_t)(row0 + r8 + q) * D))[F.lane + 64 * j];
#pragma unroll
            for (int q = 0; q < 8; ++q) { const int row = row0 + r8 + q; f32x4 v[4];
#pragma unroll
                for (int j = 0; j < 4; ++j) v[j] = (f32x4){bflo(xr[q][j].x), bfhi(xr[q][j].x), bflo(xr[q][j].y), bfhi(xr[q][j].y)};
                row_adaln(v, a->in[I_NFFNG] + l * 1024, mb + 3072, mb + 4096, F.lane);
                unsigned char* h8 = (unsigned char*)H + (size_t)row * D;
                row_store_fp8_wt(h8, F.lane, v, Q_SA);
            }
        }
        __syncthreads();
        if (F.tid < 32) { cnt[chunk * 32 + F.tid] = hist[F.tid]; hist[F.tid] = 0; }
    }
    __syncthreads();
}

__device__ __forceinline__ void p9_slots(ArgP a, const Ctx& F) {
    unsigned char* ws = a->ws;
    const int* cnt = (const int*)(ws + RT_CNT); const int* toke = (const int*)(ws + RT_TOKE); const int* rank = (const int*)(ws + RT_RANK);
    int* pslot = (int*)(ws + RT_PSLOT); int* stok = (int*)(ws + RT_STOK); int* tilee = (int*)(ws + RT_TILEE);
    LAS int* tot = (LAS int*)(F.lds); LAS int* off = tot + 32; LAS int* pst = tot + 64;
    for (int chunk = F.vcu; chunk < NCHUNK; chunk += F.G) {
        if (F.tid < 64) tot[F.tid] = 0;
        __syncthreads();
        { const int e = F.tid & 31, part = F.tid >> 5; int t = 0, o = 0;
          int v[NCHUNK / 16];
#pragma unroll
          for (int i = 0; i < NCHUNK / 16; ++i) v[i] = cnt[(part + 16 * i) * 32 + e];
#pragma unroll
          for (int i = 0; i < NCHUNK / 16; ++i) { t += v[i]; if (part + 16 * i < chunk) o += v[i]; }
          __hip_atomic_fetch_add(&tot[e], t, __ATOMIC_RELAXED, __HIP_MEMORY_SCOPE_WORKGROUP); __hip_atomic_fetch_add(&off[e], o, __ATOMIC_RELAXED, __HIP_MEMORY_SCOPE_WORKGROUP); }
        __syncthreads();
        if (F.tid == 0) { int p = 0; for (int e = 0; e < 32; ++e) { pst[e] = p; p += (tot[e] + 255) & ~255; } pst[32] = p; }
        __syncthreads();
        { const int pi = chunk * CHUNK_ROWS * 4 + F.tid; const int e = toke[pi]; const int slot = pst[e] + off[e] + rank[pi]; pslot[pi] = slot; stok[slot] = pi >> 2; }
        if (chunk == 0) {
            for (int e = 0; e < 32; ++e) { const int s0 = pst[e] + tot[e], s1 = pst[e + 1]; for (int s = s0 + F.tid; s < s1; s += NTHR) stok[s] = 0;
                for (int t = (pst[e] >> 8) + F.tid; t < (pst[e + 1] >> 8); t += NTHR) tilee[t] = e; }
            if (F.tid == 0) tilee[1023] = pst[32] >> 8;
        }
        __syncthreads();
    }
}

__device__ __forceinline__ void p12_combine(ArgP a, const Ctx& F, int l) {
    unsigned char* ws = a->ws;
    bf16* X1 = (bf16*)(ws + WS_X1); const bf16* YB = (const bf16*)(ws + WS_YB); bf16* H = (bf16*)(ws + WS_H);
    const int* pslot = (const int*)(ws + RT_PSLOT); const float* gate = (const float*)(ws + RT_GATE);
    const float* mod = (const float*)(ws + WS_MOD);
    const int gw = F.vcu * NWAVES + F.wave, NGW = F.G * NWAVES;
    for (int chr = gw; chr < (NTOK / 16) * (l == 1 ? PROBE_R_COMB : 1); chr += NGW) {
        const int chunk = chr & (NTOK / 16 - 1), rowb = chunk * 16;
#ifdef PROBE_COMB_FAKE
        const bool fake = chr >= NTOK / 16;
        const int ps = fake ? rowb * 4 + (int)F.lane : pslot[rowb * 4 + F.lane]; const float gt = gate[rowb * 4 + F.lane];
        float* outp = fake ? (float*)(ws + WS_SS) : a->out;
#else
        const int ps = pslot[rowb * 4 + F.lane]; const float gt = gate[rowb * 4 + F.lane];
        float* outp = a->out;
#endif
        const float* g2 = mod + (size_t)(l * 16 + (rowb >> 11)) * 6144 + 5120;
        f32x4 g2v[4], pa[4], pb[4];
#pragma unroll
        for (int j = 0; j < 4; ++j) { g2v[j] = ((const f32x4*)g2)[F.lane + 64 * j];
            if (l == 0) { const float* m1 = mod + (size_t)(16 + (rowb >> 11)) * 6144; pa[j] = ((const f32x4*)(a->in[I_NMIXG] + 1024))[F.lane + 64 * j] * (((const f32x4*)(m1 + 1024))[F.lane + 64 * j] + 1.0f); pb[j] = ((const f32x4*)m1)[F.lane + 64 * j]; }
            else { pa[j] = ((const f32x4*)a->in[I_FING])[F.lane + 64 * j]; pb[j] = (f32x4){0.f, 0.f, 0.f, 0.f}; } }
#pragma unroll 1
        for (int i = 0; i < 16; i += 2) {
            u32x2 xr[2][4], yr[2][4][4]; float gv[2][4];
#pragma unroll
            for (int q = 0; q < 2; ++q) { const int row = rowb + i + q;
#pragma unroll
                for (int j = 0; j < 4; ++j) xr[q][j] = ((const u32x2*)(X1 + (size_t)row * D))[F.lane + 64 * j];
#pragma unroll
                for (int k = 0; k < 4; ++k) { const int slot = __builtin_amdgcn_readlane(ps, 4 * (i + q) + k); gv[q][k] = __builtin_bit_cast(float, __builtin_amdgcn_readlane(__builtin_bit_cast(int, gt), 4 * (i + q) + k));
                    const u32x2* yp = (const u32x2*)(YB + (size_t)slot * D);
#pragma unroll
                    for (int j = 0; j < 4; ++j) yr[q][k][j] = yp[F.lane + 64 * j]; } }
#pragma unroll
            for (int q = 0; q < 2; ++q) { const int row = rowb + i + q;
                f32x4 v[4];
#pragma unroll
                for (int j = 0; j < 4; ++j) { f32x4 mm = (f32x4){0.f, 0.f, 0.f, 0.f};
#pragma unroll
                    for (int k = 0; k < 4; ++k) { const u32x2 y = yr[q][k][j]; mm.x += gv[q][k] * bflo(y.x); mm.y += gv[q][k] * bfhi(y.x); mm.z += gv[q][k] * bflo(y.y); mm.w += gv[q][k] * bfhi(y.y); }
                    v[j] = (f32x4){bflo(xr[q][j].x), bfhi(xr[q][j].x), bflo(xr[q][j].y), bfhi(xr[q][j].y)} + g2v[j] * mm; }
                if (l == 0) {
                    row_store_bf16_wt(X1 + (size_t)row * D, F.lane, v);
                    { const float rs = row_rstd(v);
#pragma unroll
                      for (int j = 0; j < 4; ++j) v[j] = (v[j] * rs) * pa[j] + pb[j]; }
                    unsigned char* h8 = (unsigned char*)H + (size_t)row * D;
                    row_store_fp8_wt(h8, F.lane, v, Q_SA);
                } else {
                    const float rs = row_rstd(v);
#pragma unroll
                    for (int j = 0; j < 4; ++j) st16_wt((f32x4*)(outp + (size_t)row * D) + F.lane + 64 * j, __builtin_bit_cast(u32x4, (v[j] * rs) * pa[j]));
                }
            }
        }
    }
}

__device__ __forceinline__ void p14_conv(ArgP a, const Ctx& F) {
    const bf16* GLU = (const bf16*)(a->ws + WS_GLU); bf16* H = (bf16*)(a->ws + WS_H);
    LAS float* CV = (LAS float*)F.lds;
    const int c0 = 2 * F.tid;
    float w0[31], w1[31];
#pragma unroll
    for (int j = 0; j < 31; ++j) { const f32x2 w = *(const f32x2*)(a->in[I_DWW] + j * 1024 + c0); w0[j] = w.x; w1[j] = w.y; }
    const f32x2 db = *(const f32x2*)(a->in[I_DWB] + c0);
    f32x4 lng[4], lnb[4];
#pragma unroll
    for (int j = 0; j < 4; ++j) { lng[j] = ((const f32x4*)a->in[I_CLNG])[F.lane + 64 * j]; lnb[j] = ((const f32x4*)a->in[I_CLNB])[F.lane + 64 * j]; }
    for (int itr = F.vcu; itr < (NTOK / 32) * PROBE_R_CONV; itr += F.G) { const int it = itr & (NTOK / 32 - 1);
        const int b = it >> 6, t0 = (it & 63) * 32;
        const bf16* base = GLU + (size_t)b * T * D + c0;
        float wa[31], wb[31];
        unsigned nxt[32];
        {   unsigned raw[30];
#pragma unroll
            for (int j = 0; j < 30; ++j) { const int t = t0 - 15 + j; raw[j] = (t >= 0 && t < T) ? *(const unsigned*)(base + (size_t)t * D) : 0u; }
#pragma unroll
            for (int j = 0; j < 32; ++j) { const int t = t0 + j + 15; nxt[j] = (t < T) ? *(const unsigned*)(base + (size_t)t * D) : 0u; }
#pragma unroll
            for (int j = 0; j < 30; ++j) { wa[j + 1] = bflo(raw[j]); wb[j + 1] = bfhi(raw[j]); } }
#pragma unroll
        for (int tl = 0; tl < 32; ++tl) {
#pragma unroll
            for (int j = 0; j < 30; ++j) { wa[j] = wa[j + 1]; wb[j] = wb[j + 1]; }
            wa[30] = bflo(nxt[tl]); wb[30] = bfhi(nxt[tl]);
            float s0 = db.x, s1 = db.y;
#pragma unroll
            for (int j = 0; j < 31; ++j) { s0 += wa[j] * w0[j]; s1 += wb[j] * w1[j]; }
            *(LAS f32x2*)(CV + tl * 1024 + c0) = (f32x2){s0, s1};
            if ((tl & 3) == 3) __builtin_amdgcn_sched_barrier(0);
        }
        __syncthreads();
#pragma unroll 1
        for (int q = 0; q < 4; ++q) {
            const int tl = F.wave * 4 + q; f32x4 v[4];
#pragma unroll
            for (int j = 0; j < 4; ++j) v[j] = ((const LAS f32x4*)(CV + tl * 1024))[F.lane + 64 * j];
            float s = 0.f;
#pragma unroll
            for (int j = 0; j < 4; ++j) s += (v[j].x + v[j].y) + (v[j].z + v[j].w);
            const float mu = wave_sum(s) * (1.0f / D); float sq = 0.f;
#pragma unroll
            for (int j = 0; j < 4; ++j) { v[j] -= mu; sq += (v[j].x * v[j].x + v[j].y * v[j].y) + (v[j].z * v[j].z + v[j].w * v[j].w); }
            const float rs = __frsqrt_rn(wave_sum(sq) * (1.0f / D) + 1e-5f);
#pragma unroll
            for (int j = 0; j < 4; ++j) { const f32x4 gg = lng[j], bb = lnb[j];
                f32x4 y = v[j] * rs * gg + bb; y.x *= sigmoidf_(y.x); y.y *= sigmoidf_(y.y); y.z *= sigmoidf_(y.z); y.w *= sigmoidf_(y.w); v[j] = y; }
            unsigned char* h8 = (unsigned char*)H + (size_t)(b * T + t0 + tl) * D;
            row_store_fp8_wt(h8, F.lane, v, Q_SA);
        }
        __syncthreads();
    }
}

#ifndef MK_ONE_LAUNCH
#define MK_ONE_LAUNCH 1
#endif
constexpr int NPHASE = 21;
constexpr size_t TSTEP = (size_t)256 * 1024 * 2;

__global__ void __launch_bounds__(NTHR, 2) fwd(Args a_unused) {
    extern __shared__ __attribute__((aligned(16))) unsigned char lds_raw[];
    Ctx F; F.lds = (LAS unsigned char*)lds_raw; F.tid = threadIdx.x; F.lane = F.tid & 63; F.wave = __builtin_amdgcn_readfirstlane(F.tid >> 6);
    F.G = gridDim.x; { const int bx = blockIdx.x; F.vcu = (F.G % 8 == 0) ? (bx % 8) * (F.G / 8) + bx / 8 : bx; }
    ArgP a = (ArgP)__builtin_amdgcn_kernarg_segment_ptr();
    unsigned char* ws = a->ws;
    if (F.tid < 64) ((LAS unsigned*)(F.lds + LDSCTL_OFF))[F.tid] = 0u;
    __syncthreads();
    XcdBarrier bar; bar.bar = (unsigned*)(ws + WS_CTL) + CW_BAR; bar.x = 0; bar.st = nullptr;
    if (MK_ONE_LAUNCH) bar = xcd_barrier_post((unsigned*)(ws + WS_CTL) + CW_BAR, (volatile LAS unsigned*)(F.lds + LDSCTL_OFF), F.tid == 0);
    const int lo = a->ph_lo, hi = a->ph_hi;
#ifndef PH_MASK
#define PH_MASK 0xffffffffu
#endif
#define IN(k) ((((PH_MASK) >> ((k) >= 16 ? (k) - 8 : (k))) & 1u) && lo <= (k) && (k) < hi)
#ifdef PROBE_SEAM2
#define SEAM(k) do { if (IN((k) + 1) || ((k) == 2 && IN(4))) { xcd_barrier(bar, F.wave == 0 && lane_id() == 0); xcd_barrier(bar, F.wave == 0 && lane_id() == 0); xcd_barrier(bar, F.wave == 0 && lane_id() == 0); } } while (0)
#else
#define SEAM(k) do { if (IN((k) + 1) || ((k) == 2 && IN(4))) xcd_barrier(bar, F.wave == 0 && lane_id() == 0); } while (0)
#endif
#define FRESH() do { F.tid = F.wave * 64 + lane_id(); asm volatile("" : "+v"(F.tid)); F.lane = F.tid & 63; a = (ArgP)__builtin_amdgcn_kernarg_segment_ptr(); asm volatile("" : "+s"(a)); ws = a->ws; } while (0)
#define MODP ((const float*)(ws + WS_MOD))
#define Hb ((bf16*)(ws + WS_H))
#define TILE_E ((const int*)(ws + RT_TILEE))
#define SLOT_TOK ((const int*)(ws + RT_STOK))

    if (IN(0)) { FRESH(); p0_prologue(a, F); SEAM(0); }
    if (IN(1)) { FRESH(); p1_adaln0(a, F); SEAM(1); }
    if (IN(2)) {
        FRESH();
        pg8::OrderPlain S; S.init(MROWS / 256, NIN / 256, F.G, (int)blockIdx.x); S.A = (const char*)Hb; S.Bt = (const char*)(ws + WS_WIN); S.tstep = TSTEP / 2; S.reps = PROBE_R_DENSE;
        EpiInproj E{(bf16*)(ws + WS_P), (bf16*)(ws + WS_VT), (bf16*)(ws + WS_KB), F.lds};
        pg8::gemm_phase<EpiInproj, pg8::OrderPlain, false, true>(F.lds, 512, S, E, F.tid);
        SEAM(2);
    }
    if (IN(5)) { FRESH(); p5_natten(a, F); }
    if (IN(4)) { FRESH(); p4_scan(a, F); SEAM(5); }
    if (IN(6)) { FRESH(); p6_post(a, F); SEAM(6); }
    if (IN(7)) {
        FRESH();
        pg8::OrderPlain S; S.init(NTOK / 256, 4, F.G, (int)blockIdx.x); S.A = (const char*)Hb; S.Bt = (const char*)(ws + WS_WOUT); S.tstep = TSTEP / 2; S.reps = PROBE_R_DENSE2;
        EpiResid<false> E{a->in[I_X], (bf16*)(ws + WS_X1), MODP + 2048, nullptr};
        pg8::gemm_phase<EpiResid<false>, pg8::OrderPlain, false, true>(F.lds, 512, S, E, F.tid);
        SEAM(7);
    }
#pragma unroll 1
    for (int l = 0; l < 2; ++l) {
        const int pb = l == 0 ? 8 : 16;
        if (IN(pb)) { FRESH(); p8_router(a, F, l); SEAM(pb); }
        if (IN(pb + 1)) { FRESH(); p9_slots(a, F); SEAM(pb + 1); }
        if (IN(pb + 2)) {
        FRESH();
            pg8::OrderMoe S; S.init(TILE_E[1023], 8, F.G, (int)blockIdx.x); S.A = (const char*)Hb; S.Bt = (const char*)(ws + WS_EW1) + (size_t)l * 32 * 2048 * 1024; S.tstep = TSTEP / 2;
            S.estride = (size_t)2048 * 1024; S.tile_e = TILE_E; S.slot_tok = SLOT_TOK; S.reps = PROBE_R_MOEG;
            EpiPair<0> E{(bf16*)(ws + WS_ACT), a->in[I_EB1] + (size_t)l * 32 * 2048, TILE_E};
            pg8::gemm_phase<EpiPair<0>, pg8::OrderMoe, true, true>(F.lds, 512, S, E, F.tid);
        SEAM(pb + 2);
        }
        if (IN(pb + 3)) {
        FRESH();
            pg8::OrderMoe S; S.init(TILE_E[1023], 4, F.G, (int)blockIdx.x); S.A = (const char*)(ws + WS_ACT); S.Bt = (const char*)(ws + WS_EW2) + (size_t)l * 32 * 1024 * 1024; S.tstep = TSTEP / 2;
            S.estride = (size_t)1024 * 1024; S.tile_e = TILE_E; S.slot_tok = SLOT_TOK; S.reps = PROBE_R_MOEG;
            EpiMoe2 E{(bf16*)(ws + WS_YB), a->in[I_EB2] + (size_t)l * 32 * 1024, TILE_E};
            pg8::gemm_phase<EpiMoe2, pg8::OrderMoe, false, true>(F.lds, 512, S, E, F.tid);
        SEAM(pb + 3);
        }
        if (IN(pb + 4)) { FRESH(); p12_combine(a, F, l); SEAM(pb + 4); }
        if (l == 0) {
            if (IN(13)) {
        FRESH();
                pg8::OrderPlain S; S.init(NTOK / 256, 8, F.G, (int)blockIdx.x); S.A = (const char*)Hb; S.Bt = (const char*)(ws + WS_PW1); S.tstep = TSTEP / 2; S.reps = PROBE_R_DENSE2;
                EpiPair<1> E{(bf16*)(ws + WS_GLU), a->in[I_PW1B], nullptr};
                pg8::gemm_phase<EpiPair<1>, pg8::OrderPlain, false, true>(F.lds, 512, S, E, F.tid);
        SEAM(13);
            }
            if (IN(14)) { FRESH(); p14_conv(a, F); SEAM(14); }
            if (IN(15)) {
        FRESH();
                pg8::OrderPlain S; S.init(NTOK / 256, 4, F.G, (int)blockIdx.x); S.A = (const char*)Hb; S.Bt = (const char*)(ws + WS_PW2); S.tstep = TSTEP / 2;
                EpiResid<true> E{(const void*)(ws + WS_X1), (bf16*)(ws + WS_X1), MODP + 16 * 6144 + 2048, a->in[I_PW2B]};
                pg8::gemm_phase<EpiResid<true>, pg8::OrderPlain, false, true>(F.lds, 512, S, E, F.tid);
        SEAM(15);
            }
        }
    }
#undef IN
#undef SEAM
}

extern "C" void kernel_launch(void* const* d_in, const int* in_sizes, int n_in, void* d_out, int out_size, void* d_ws, size_t ws_size, hipStream_t stream) {
    static int grid = 0;
    if (grid == 0) {
        if (n_in != 38 || out_size != NTOK * D || ws_size < WS_END) { fprintf(stderr, "kernel_launch: unexpected problem (n_in %d, out %d, ws %zu < %zu)\n", n_in, out_size, ws_size, (size_t)WS_END); grid = -1; return; }
        int dev = 0, cus = 0, per_cu = 0;
        if (hipGetDevice(&dev) != hipSuccess || hipDeviceGetAttribute(&cus, hipDeviceAttributeMultiprocessorCount, dev) != hipSuccess) { grid = -1; return; }
        if (hipFuncSetAttribute((const void*)fwd, hipFuncAttributeMaxDynamicSharedMemorySize, LDS_BYTES) != hipSuccess) { fprintf(stderr, "kernel_launch: hipFuncSetAttribute failed\n"); grid = -1; return; }
        if (hipOccupancyMaxActiveBlocksPerMultiprocessor(&per_cu, (const void*)fwd, NTHR, LDS_BYTES) != hipSuccess || per_cu < 1)
            fprintf(stderr, "kernel_launch: note: occupancy query reports %d workgroups per CU\n", per_cu);
        (void)hipGetLastError();
        grid = cus;
    }
    if (grid < 0) return;
    if (hipMemsetAsync((char*)d_ws + WS_CTL, 0, CTL_ZERO_BYTES, stream) != hipSuccess) return;
    Args a{};
    for (int i = 0; i < 38; ++i) a.in[i] = (const float*)d_in[i];
    a.out = (float*)d_out; a.ws = (unsigned char*)d_ws;
#if MK_ONE_LAUNCH
    a.ph_lo = 0; a.ph_hi = NPHASE;
    hipLaunchKernelGGL(fwd, dim3(grid), dim3(NTHR), LDS_BYTES, stream, a);
#else
    for (int p = 0; p < NPHASE; ++p) { a.ph_lo = p; a.ph_hi = p + 1; hipLaunchKernelGGL(fwd, dim3(grid), dim3(NTHR), LDS_BYTES, stream, a); }
#endif
}
```

```cpp
#include <hip/hip_runtime.h>
#include <cstdio>
#include <cstdint>

#define GAS __attribute__((address_space(1)))
#define LAS __attribute__((address_space(3)))
typedef unsigned short bf16;
typedef short bf16x8 __attribute__((ext_vector_type(8)));
typedef float f32x4 __attribute__((ext_vector_type(4)));
typedef float f32x2 __attribute__((ext_vector_type(2)));
typedef unsigned u32x4 __attribute__((ext_vector_type(4)));
typedef unsigned u32x2 __attribute__((ext_vector_type(2)));

__device__ __forceinline__ unsigned f2bf(float f) { unsigned u = __builtin_bit_cast(unsigned, f); return (u + 0x7fffu + ((u >> 16) & 1u)) >> 16; }
__device__ __forceinline__ unsigned pk2(float lo, float hi) { return f2bf(lo) | (f2bf(hi) << 16); }
__device__ __forceinline__ float bflo(unsigned u) { return __builtin_bit_cast(float, u << 16); }
__device__ __forceinline__ float bfhi(unsigned u) { return __builtin_bit_cast(float, u & 0xffff0000u); }
__device__ __forceinline__ float sigmoidf_(float x) { return __builtin_amdgcn_rcpf(1.0f + __expf(-x)); }
__device__ __forceinline__ float wave_sum(float v) {
#pragma unroll
    for (int o = 1; o < 64; o <<= 1) v += __shfl_xor(v, o);
    return v;
}

namespace pg8 {
constexpr int BM = 256, BK = 64, HALF = 128, HTB = HALF * BK * 2, STAGE_BYTES = 8 * HTB, NXCD = 8, WGM = 4;
__host__ __device__ __forceinline__ int lds_byte(int r, int c) { const int st = (r >> 4) * 2 + (c >> 5), rr = r & 15, cc = c & 31, ob = rr * 64 + cc * 2; return st * 1024 + (ob ^ (((ob >> 9) & 1) << 5)); }
__host__ __device__ __forceinline__ void stage_rc(int b, int& R, int& C) { const int st = b / 1024, sb = b % 1024, swz = sb ^ (((sb >> 9) & 1) << 5); R = (st >> 1) * 16 + swz / 64; C = (st & 1) * 32 + (swz % 64) / 2; }
__host__ __device__ __forceinline__ int perm32(int rho) { const int n = rho >> 4, i = rho & 15; return 8 * (i >> 2) + 4 * n + (i & 3); }

struct Unit { int pm, pn, e; };

struct OrderBase {
    int nM, nN, nwg, G, c, reps;
    __device__ __forceinline__ void init(int nM_, int nN_, int G_, int c_) { nM = nM_; nN = nN_; nwg = nM * nN; G = G_; c = c_; reps = 1; }
    __device__ __forceinline__ bool next(int i, Unit& u) const {
#ifdef PROBE_DUP
        const long L = (long)(i >> 1) * G + c; if (L >= (long)nwg * reps) return false;
#else
        const long L = (long)i * G + c; if (L >= (long)nwg * reps) return false;
#endif
        int wgid = (int)(L % nwg); { const int q = nwg / NXCD, r = nwg % NXCD, xcd = wgid % NXCD, off = wgid / NXCD; wgid = (xcd < r ? xcd * (q + 1) : r * (q + 1) + (xcd - r) * q) + off; }
        const int nig = WGM * nN, gid = wgid / nig, fm = gid * WGM, gsz = (nM - fm) < WGM ? (nM - fm) : WGM;
        u.pm = fm + ((wgid % nig) % gsz); u.pn = (wgid % nig) / gsz; return true;
    }
};
struct OrderPlain : OrderBase {
    static constexpr bool HAS_E = false;
    const char* A; const char* Bt; size_t tstep;
    __device__ __forceinline__ const char* a_base(const Unit& u) const { return A + (size_t)u.pm * tstep; }
    __device__ __forceinline__ const char* b_base(const Unit& u) const { return Bt + (size_t)u.pn * tstep; }
    __device__ __forceinline__ const int* a_rows(const Unit&) const { return nullptr; }
};
struct OrderMoe : OrderBase {
    static constexpr bool HAS_E = true;
    const char* A; const char* Bt; size_t tstep, estride; const int* tile_e; const int* slot_tok;
    __device__ __forceinline__ const char* a_base(const Unit& u) const { return A + (size_t)u.pm * tstep; }
    __device__ __forceinline__ const char* b_base(const Unit& u) const { return Bt + (size_t)u.e * estride + (size_t)u.pn * tstep; }
    __device__ __forceinline__ const int* a_rows(const Unit& u) const { return slot_tok + u.pm * 256; }
};

typedef __bf16 bf16x2_t __attribute__((ext_vector_type(2)));
__device__ __forceinline__ unsigned cvt_pk_bf16(float lo, float hi) { const f32x2 v = {lo, hi}; return __builtin_bit_cast(unsigned, __builtin_convertvector(v, bf16x2_t)); }

typedef int i32x8 __attribute__((ext_vector_type(8)));
typedef int i32x4 __attribute__((ext_vector_type(4)));
__device__ __forceinline__ i32x8 cat8(bf16x8 lo, bf16x8 hi) { const i32x4 a = __builtin_bit_cast(i32x4, lo), b = __builtin_bit_cast(i32x4, hi); return __builtin_shufflevector(a, b, 0, 1, 2, 3, 4, 5, 6, 7); }
template <class Epi, class Sched, bool GATHER, bool FP8 = false>
__device__ __forceinline__ void gemm_phase(LAS unsigned char* lds, const int K, const Sched& S, const Epi& E, int tid) {
    asm volatile("" : "+v"(tid));
    const int wid = __builtin_amdgcn_readfirstlane(tid >> 6), lane = tid & 63, wr = wid >> 2, wc = wid & 3, fr = lane & 15, fq = lane >> 4;
    const int nt = K / BK;
    unsigned voffA[2], voffB[2]; int gR[2]; unsigned gC[2];
#pragma unroll
    for (int i = 0; i < 2; ++i) { int R, C; stage_rc(tid * 16 + i * 8192, R, C); const int Rw = Epi::WIDE ? 64 * (R >> 5) : (R & ~31); const int Rb = Rw + (Epi::PERM ? perm32(R & 31) : (R & 31));
        voffA[i] = (unsigned)(R * K + C) * 2u; voffB[i] = (unsigned)(Rb * K + C) * 2u; gR[i] = R; gC[i] = (unsigned)C * 2u; }
    const size_t kstep = (size_t)(BK * 2);
    const size_t hstep = (size_t)HALF * K * 2;
    const size_t hstepB = Epi::WIDE ? (size_t)32 * K * 2 : hstep;
    const unsigned ldsw = (unsigned)wid * 1024u;
    const int aoff = lds_byte(wr * 64 + fr, fq * 8), boff = lds_byte(wc * 32 + fr, fq * 8);
#define PG8_SA(b, h) (((b) * 2 + (h)) * HTB)
#define PG8_SB(b, h) ((4 + (b) * 2 + (h)) * HTB)
#define PG8_STAGE(bufoff, gbase, voff) do { _Pragma("unroll") for (int _i = 0; _i < 2; ++_i) \
        __builtin_amdgcn_global_load_lds((const unsigned*)((const char*)(gbase) + (voff)[_i]), (LAS unsigned*)(lds + (bufoff) + ldsw + _i * 8192), 16, 0, 0); } while (0)
#define PG8_STAGE_A(bufoff, base, h, nx) do { if constexpr (GATHER) { if (nx) PG8_STAGE(bufoff, base, go2[h]); else PG8_STAGE(bufoff, base, goc[h]); } \
        else PG8_STAGE(bufoff, (base) + (h) * hstep, voffA); } while (0)
#define PG8_LDA(dst, b, h) do { _Pragma("unroll") for (int m = 0; m < 4; ++m) dst[m] = cat8(*(const LAS bf16x8*)(lds + PG8_SA(b, h) + aoff + m * 2048), *(const LAS bf16x8*)(lds + PG8_SA(b, h) + aoff + m * 2048 + 1024)); } while (0)
#define PG8_LDB(dst, b, h) do { _Pragma("unroll") for (int n = 0; n < 2; ++n) dst[n] = cat8(*(const LAS bf16x8*)(lds + PG8_SB(b, h) + boff + n * 2048), *(const LAS bf16x8*)(lds + PG8_SB(b, h) + boff + n * 2048 + 1024)); } while (0)
#define PG8_LO(x) __builtin_bit_cast(bf16x8, __builtin_shufflevector(x, x, 0, 1, 2, 3))
#define PG8_HI(x) __builtin_bit_cast(bf16x8, __builtin_shufflevector(x, x, 4, 5, 6, 7))
#define PG8_MMA(ai, bj, At, Bt) do { __builtin_amdgcn_s_setprio(1); _Pragma("unroll") for (int m = 0; m < 4; ++m) _Pragma("unroll") for (int n = 0; n < 2; ++n) { \
        if constexpr (FP8) asm volatile("v_mfma_f32_16x16x128_f8f6f4 %0, %1, %2, %0" : "+v"(acc[ai][bj][m][n]) : "v"(Bt[n]), "v"(At[m])); \
        else { acc[ai][bj][m][n] = __builtin_amdgcn_mfma_f32_16x16x32_bf16(PG8_LO(Bt[n]), PG8_LO(At[m]), acc[ai][bj][m][n], 0, 0, 0); \
               acc[ai][bj][m][n] = __builtin_amdgcn_mfma_f32_16x16x32_bf16(PG8_HI(Bt[n]), PG8_HI(At[m]), acc[ai][bj][m][n], 0, 0, 0); } } \
        __builtin_amdgcn_s_setprio(0); } while (0)
#define PG8_MMAZ(ai, bj, At, Bt) do { __builtin_amdgcn_s_setprio(1); _Pragma("unroll") for (int m = 0; m < 4; ++m) _Pragma("unroll") for (int n = 0; n < 2; ++n) { \
        if constexpr (FP8) asm volatile("v_mfma_f32_16x16x128_f8f6f4 %0, %1, %2, 0" : "=&v"(acc[ai][bj][m][n]) : "v"(Bt[n]), "v"(At[m])); \
        else { acc[ai][bj][m][n] = __builtin_amdgcn_mfma_f32_16x16x32_bf16(PG8_LO(Bt[n]), PG8_LO(At[m]), (f32x4){0.f, 0.f, 0.f, 0.f}, 0, 0, 0); \
               acc[ai][bj][m][n] = __builtin_amdgcn_mfma_f32_16x16x32_bf16(PG8_HI(Bt[n]), PG8_HI(At[m]), acc[ai][bj][m][n], 0, 0, 0); } } \
        __builtin_amdgcn_s_setprio(0); } while (0)
#define PG8_WAIT_V(n) asm volatile("s_waitcnt vmcnt(" #n ")" ::: "memory")
#define PG8_WAIT_L(n) asm volatile("s_waitcnt lgkmcnt(" #n ")" ::: "memory")
#define PG8_BAR __builtin_amdgcn_s_barrier()
#define PG8_SCHED __builtin_amdgcn_sched_barrier(0)
#define PG8_GOFF(dst, rows) do { _Pragma("unroll") for (int _h = 0; _h < 2; ++_h) _Pragma("unroll") for (int _i = 0; _i < 2; ++_i) \
        dst[_h][_i] = (unsigned)(rows)[_h * HALF + gR[_i]] * (unsigned)(K * 2) + gC[_i]; } while (0)
    Unit cur, nxt; int ui = 0;
    if (!S.next(0, cur)) return;
    cur.e = 0; if constexpr (Sched::HAS_E) cur.e = __builtin_amdgcn_readfirstlane(S.tile_e[cur.pm]);
    f32x4 acc[2][2][4][2];
    i32x8 At[4], B0[2], B1[2];
    const int fp8_one = 0x7f7f7f7f;
    unsigned goc[2][2], gon[2][2], go2[2][2];
    const char* cA = GATHER ? S.A : S.a_base(cur); const char* cB = S.b_base(cur);
    if constexpr (GATHER) { const int* rows = S.a_rows(cur); PG8_GOFF(goc, rows);
#pragma unroll
        for (int h = 0; h < 2; ++h)
#pragma unroll
            for (int i = 0; i < 2; ++i) { gon[h][i] = goc[h][i]; go2[h][i] = goc[h][i]; } }
    PG8_STAGE(PG8_SB(0, 0), cB, voffB); PG8_STAGE(PG8_SB(0, 1), cB + hstepB, voffB); PG8_STAGE_A(PG8_SA(0, 0), cA, 0, 0); PG8_STAGE_A(PG8_SA(0, 1), cA, 1, 0);
    if (wr == 1) PG8_BAR;
    PG8_WAIT_V(2); PG8_BAR;
    PG8_STAGE(PG8_SB(1, 0), cB + kstep, voffB); PG8_STAGE_A(PG8_SA(1, 0), cA + kstep, 0, 0); PG8_STAGE(PG8_SB(1, 1), cB + hstepB + kstep, voffB);
    PG8_WAIT_V(6); PG8_BAR;
    for (;;) {
        const bool has_next = S.next(ui + 1, nxt);
        nxt.e = cur.e; if constexpr (Sched::HAS_E) { if (has_next) { const int* ep = S.tile_e + nxt.pm; int ev; asm volatile("global_load_dword %0, %1, off" : "=v"(ev) : "v"(ep) : "memory"); nxt.e = ev; } }
        const char* nA = has_next ? (GATHER ? S.A : S.a_base(nxt)) : cA;
#define PG8_TRIP(MMAF) do { \
            const bool last = (t == nt - 2); \
            const char* a1 = cA + (size_t)(t + 1) * kstep; \
            const char* nB = cB; if (last && has_next) { if constexpr (Sched::HAS_E) { int ev = nxt.e; asm volatile("" : "+v"(ev)); nxt.e = __builtin_amdgcn_readfirstlane(ev); } \
                nB = S.b_base(nxt); } \
            const char* a2 = last ? nA : cA + (size_t)(t + 2) * kstep; const char* b2 = last ? nB : cB + (size_t)(t + 2) * kstep; \
            const char* a3 = a2 + kstep; const char* b3 = b2 + kstep; \
            if constexpr (GATHER) { \
                if (t == 0 && has_next) { const int* rows = S.a_rows(nxt); \
_Pragma("unroll") \
                    for (int h = 0; h < 2; ++h) \
_Pragma("unroll") \
                        for (int i = 0; i < 2; ++i) { const int* rp = rows + h * HALF + gR[i]; unsigned rv; asm volatile("global_load_dword %0, %1, off" : "=v"(rv) : "v"(rp) : "memory"); gon[h][i] = rv; } } \
                if (last && has_next) { \
_Pragma("unroll") \
                    for (int h = 0; h < 2; ++h) \
_Pragma("unroll") \
                        for (int i = 0; i < 2; ++i) { unsigned rv = gon[h][i]; asm volatile("" : "+v"(rv)); gon[h][i] = rv * (unsigned)(K * 2) + gC[i]; go2[h][i] = gon[h][i]; } } \
            } \
            PG8_LDB(B0, 0, 0); PG8_LDB(B1, 0, 1); PG8_SCHED; PG8_LDA(At, 0, 0); PG8_STAGE_A(PG8_SA(1, 1), a1, 1, 0); \
            PG8_WAIT_V(8); PG8_WAIT_L(0); PG8_BAR; MMAF(0, 0, At, B0); MMAF(0, 1, At, B1); PG8_BAR; PG8_SCHED; \
            PG8_LDA(At, 0, 1); PG8_STAGE(PG8_SB(0, 0), b2, voffB); PG8_STAGE(PG8_SB(0, 1), b2 + hstepB, voffB); PG8_STAGE_A(PG8_SA(0, 0), a2, 0, 1); \
            PG8_WAIT_V(8); PG8_WAIT_L(0); PG8_BAR; MMAF(1, 0, At, B0); MMAF(1, 1, At, B1); PG8_BAR; PG8_SCHED; \
            PG8_LDB(B0, 1, 0); PG8_LDB(B1, 1, 1); PG8_SCHED; PG8_LDA(At, 1, 0); PG8_STAGE_A(PG8_SA(0, 1), a2, 1, 1); \
            PG8_WAIT_V(8); PG8_WAIT_L(0); PG8_BAR; PG8_MMA(0, 0, At, B0); PG8_MMA(0, 1, At, B1); PG8_BAR; PG8_SCHED; \
            PG8_LDA(At, 1, 1); PG8_STAGE(PG8_SB(1, 0), b3, voffB); PG8_STAGE(PG8_SB(1, 1), b3 + hstepB, voffB); PG8_STAGE_A(PG8_SA(1, 0), a3, 0, 1); \
            PG8_WAIT_V(8); PG8_WAIT_L(0); PG8_BAR; PG8_MMA(1, 0, At, B0); PG8_MMA(1, 1, At, B1); PG8_BAR; PG8_SCHED; \
        } while (0)
        { const int t = 0; PG8_TRIP(PG8_MMAZ); }
#pragma unroll 1
        for (int t = 2; t < nt; t += 2) { PG8_TRIP(PG8_MMA); }
#undef PG8_TRIP
        if constexpr (FP8) asm volatile("s_nop 15\n\ts_nop 15\n\ts_nop 15" ::: "memory");
        const typename Epi::Pre pre = E.pre(cur, wr, wc);
        if (wr == 0) PG8_BAR;
#ifdef PROBE_DUP
        if (PROBE_DUP == 2 || (ui & 1))
#endif
        E(acc, cur, wr, wc, fr, fq, pre);
#ifdef PROBE_EPI2
        if constexpr (FP8 && (GATHER ? (PROBE_EPI2 & 1) : (PROBE_EPI2 & 2)) != 0) { int fr2 = fr, fq2 = fq; asm volatile("" : "+v"(fr2), "+v"(fq2) :: "memory"); E(acc, cur, wr, wc, fr2, fq2, pre); }
#endif
        if (!has_next) break;
        cur = nxt; cA = nA; cB = S.b_base(nxt); ++ui;
        if constexpr (GATHER) {
#pragma unroll
            for (int h = 0; h < 2; ++h)
#pragma unroll
                for (int i = 0; i < 2; ++i) { goc[h][i] = gon[h][i]; go2[h][i] = gon[h][i]; } }
        if (wr == 1) PG8_BAR;
    }
    PG8_WAIT_V(0);
    PG8_BAR;
#undef PG8_SA
#undef PG8_SB
#undef PG8_STAGE
#undef PG8_STAGE_A
#undef PG8_LDA
#undef PG8_LDB
#undef PG8_LO
#undef PG8_HI
#undef PG8_MMA
#undef PG8_MMAZ
#undef PG8_WAIT_V
#undef PG8_WAIT_L
#undef PG8_BAR
#undef PG8_SCHED
#undef PG8_GOFF
}
}

constexpr int NWAVES = 8, NTHR = 512;
constexpr int D = 1024, NB = 16, T = 2048, NTOK = NB * T, CTXL = 256, NCTX = NB * CTXL, MROWS = NTOK + NCTX;
constexpr int PW = 3072;
constexpr int NIN = 3584;
constexpr int PC_RA = 1024, PC_GD = 1536, PC_KA = 1664, PC_VA = 2176, PC_WD = 2688, PC_AD = 2816;
constexpr int TT = CTXL + T;
constexpr int NE = 32, TOPK = 4, NPAIR = NTOK * TOPK, MAXTILES = 544, MAXSLOTS = MAXTILES * 256;
constexpr int NCHUNK = 256, CHUNK_ROWS = NTOK / NCHUNK;

#ifndef PROBE_R_PRO
#define PROBE_R_PRO 1
#endif
#ifndef PROBE_R_TERMS
#define PROBE_R_TERMS 1
#endif
#ifndef PROBE_R_SCAN
#define PROBE_R_SCAN 1
#endif
#ifndef PROBE_R_NA
#define PROBE_R_NA 1
#endif
#ifdef PROBE_NA_FAKE
#define PROBE_R_NA 2
#endif
#ifdef PROBE_COMB_FAKE
#define PROBE_R_COMB 2
#endif
#ifdef PROBE_CSLEEP
#define PROBE_CONS_SLEEP __builtin_amdgcn_s_sleep(2)
#else
#define PROBE_CONS_SLEEP do {} while (0)
#endif
#ifndef PROBE_R_MOEG
#define PROBE_R_MOEG 1
#endif
#ifndef PROBE_R_DENSE
#define PROBE_R_DENSE 1
#endif
#ifndef PROBE_R_DENSE2
#define PROBE_R_DENSE2 1
#endif
#ifndef PROBE_R_ADALN
#define PROBE_R_ADALN 1
#endif
#ifndef PROBE_R_POST
#define PROBE_R_POST 1
#endif
#ifndef PROBE_R_CONV
#define PROBE_R_CONV 1
#endif
#ifndef PROBE_R_COMB
#define PROBE_R_COMB 1
#endif
#ifndef PROBE_R_ROUTER
#define PROBE_R_ROUTER 1
#endif
constexpr size_t MiB = 1u << 20;
constexpr size_t WS_CTL = 0, CTL_ZERO_BYTES = 1 * MiB;
constexpr size_t WS_MOD = 1 * MiB;
constexpr size_t WS_SMALLW = 2 * MiB;
constexpr size_t WS_ROUTE = 3 * MiB;
constexpr size_t WS_WIN = 8 * MiB, WS_WOUT = 15 * MiB, WS_PW1 = 17 * MiB, WS_PW2 = 21 * MiB;
constexpr size_t WS_EW1 = 24 * MiB, WS_EW2 = 280 * MiB;
constexpr size_t WS_H = 408 * MiB;
constexpr size_t WS_P = 480 * MiB;
constexpr size_t WS_VT = 696 * MiB;
constexpr size_t WS_SD = 732 * MiB;
constexpr size_t WS_SS = 1308 * MiB;
constexpr size_t WS_SCL = 1452 * MiB;
constexpr size_t WS_Y = 1457 * MiB;
constexpr size_t WS_GB = 1585 * MiB;
constexpr size_t WS_X1 = 1649 * MiB;
constexpr size_t WS_END = 1777 * MiB;
constexpr size_t WS_KB = WS_SS;
constexpr size_t WS_BON1 = WS_SD;
constexpr size_t WS_ACT = WS_SD, WS_YB = WS_SD + 272 * MiB, WS_GLU = WS_P;
static_assert(WS_YB + (size_t)MAXSLOTS * D * 2 <= WS_SS && WS_ACT + (size_t)MAXSLOTS * D * 2 <= WS_YB, "ws map");
constexpr size_t RT_CNT = WS_ROUTE;
constexpr size_t RT_TOKE = RT_CNT + 32768;
constexpr size_t RT_RANK = RT_TOKE + 524288;
constexpr size_t RT_GATE = RT_RANK + 524288;
constexpr size_t RT_PSLOT = RT_GATE + 524288;
constexpr size_t RT_STOK = RT_PSLOT + 524288;
constexpr size_t RT_TILEE = RT_STOK + 589824;
static_assert(RT_TILEE + 4096 <= WS_WIN, "route map");
constexpr int CW_BAR = 4096;

constexpr int RING_BYTES = 131072, LDS_BYTES = 163840, LDSCTL_OFF = LDS_BYTES - 2048;

#define RLX_AGENT __ATOMIC_RELAXED, __HIP_MEMORY_SCOPE_AGENT

#define XB_TMO      128
#define XB_XCNT(j)  (256  + 64 * (j))
#define XB_XSUB(j)  (1280 + 64 * (j))
#define XB_XGEN(j)  (2304 + 64 * (j))
#define XB_TOP      3328
#define XB_TOPGEN   3392
#define XCD_BAR_WORDS 3456
#define XB_SPIN_CAP (1u << 18)
__device__ __forceinline__ unsigned xb_ld(unsigned* p)              { return __hip_atomic_load(p, __ATOMIC_RELAXED, __HIP_MEMORY_SCOPE_AGENT); }
__device__ __forceinline__ unsigned xb_add(unsigned* p, unsigned v) { return __hip_atomic_fetch_add(p, v, __ATOMIC_RELAXED, __HIP_MEMORY_SCOPE_AGENT); }
__device__ __forceinline__ unsigned xb_xcc_id() { return (unsigned)__builtin_amdgcn_s_getreg((3 << 11) | 20) & 0xFu; }
#define XB_SPIN(cond, bar) do { unsigned _sp = 0; while (cond) { __builtin_amdgcn_s_sleep(1); \
    if ((++_sp & 255u) == 0u) { if (xb_ld(&(bar)[XB_TMO])) break; if (_sp > XB_SPIN_CAP) { atomicAdd(&(bar)[XB_TMO], 1u); break; } } } } while (0)
struct XcdBarrier { unsigned* bar; unsigned x; volatile LAS unsigned* st; };
__device__ __forceinline__ XcdBarrier xcd_barrier_post(unsigned* bar, volatile LAS unsigned* st, bool t0) {
    XcdBarrier b; b.bar = bar; b.x = xb_xcc_id(); b.st = st;
    if (t0) (void)xb_add(&bar[XB_XCNT(b.x)], 1u);
    return b;
}
__device__ __forceinline__ void xcd_barrier_complete(unsigned* bar, unsigned x, unsigned& nloc, unsigned& nx) {
    const unsigned G = gridDim.x * gridDim.y * gridDim.z;
    unsigned sum, cnt, mine, sp = 0u;
    for (;;) {
        sum = 0u; cnt = 0u; mine = 0u;
#pragma unroll
        for (unsigned j = 0; j < 16; ++j) { const unsigned c = xb_ld(&bar[XB_XCNT(j)]); sum += c; cnt += (c > 0u) ? 1u : 0u; mine = (j == x) ? c : mine; }
        if (sum == G) break;
        __builtin_amdgcn_s_sleep(1);
        if ((++sp & 255u) == 0u) { if (xb_ld(&bar[XB_TMO])) break; if (sp > XB_SPIN_CAP) { atomicAdd(&bar[XB_TMO], 1u); break; } }
    }
    nloc = mine > 0u ? mine : 1u; nx = cnt > 0u ? cnt : 1u;
}
__device__ __forceinline__ void xcd_barrier(const XcdBarrier& b, bool t0) {
    asm volatile("s_waitcnt vmcnt(0)" ::: "memory");
    __syncthreads();
    if (t0) {
        unsigned* bar = b.bar;
        __builtin_amdgcn_s_waitcnt(0);
        unsigned nloc = b.st[0], nx = b.st[1];
        if (nloc == 0u) { xcd_barrier_complete(bar, b.x, nloc, nx); b.st[0] = nloc; b.st[1] = nx; }
        const unsigned old = xb_add(&bar[XB_XSUB(b.x)], 1u);
        const unsigned gen = old / nloc;
        if (old + 1u == (gen + 1u) * nloc) {
            __builtin_amdgcn_fence(__ATOMIC_RELEASE, "agent");
            asm volatile("s_waitcnt vmcnt(0)" ::: "memory");
            const unsigned og = xb_add(&bar[XB_TOP], 1u);
            const unsigned tg = og / nx;
            if (og + 1u == (tg + 1u) * nx) xb_add(&bar[XB_TOPGEN], 1u);
            else XB_SPIN(xb_ld(&bar[XB_TOPGEN]) == tg, bar);
            __builtin_amdgcn_fence(__ATOMIC_ACQUIRE, "agent");
            xb_add(&bar[XB_XGEN(b.x)], 1u);
            asm volatile("s_waitcnt vmcnt(0)" ::: "memory");
        } else {
            XB_SPIN(xb_ld(&bar[XB_XGEN(b.x)]) == gen, bar);
            __builtin_amdgcn_fence(__ATOMIC_ACQUIRE, "agent");
            asm volatile("s_waitcnt vmcnt(0)" ::: "memory");
        }
    }
    __syncthreads();
}

struct Args { const float* in[38]; float* out; unsigned char* ws; int ph_lo, ph_hi; };
enum { I_X = 0, I_C, I_CTX, I_CCTX, I_ADAW, I_ADAB, I_NMIXG, I_NFFNG, I_FING, I_WIN, I_MUP, I_MUN, I_W0, I_W2, I_A0, I_A2, I_G2, I_KK, I_KA, I_RK, I_LNXG, I_LNXB, I_RPB, I_WOUT,
       I_PW1W, I_PW1B, I_DWW, I_DWB, I_CLNG, I_CLNB, I_PW2W, I_PW2B, I_RW, I_RB, I_EW1, I_EB1, I_EW2, I_EB2 };

typedef const __attribute__((address_space(4))) Args* ArgP;
__device__ __forceinline__ int lane_id() { int x; asm volatile("v_mbcnt_lo_u32_b32 %0, -1, 0\n\tv_mbcnt_hi_u32_b32 %0, -1, %0" : "=v"(x)); return x; }
struct Ctx { LAS unsigned char* lds; int tid, lane, wave, vcu, G; };
constexpr float Q_SW = 64.0f, Q_SA = 8.0f, Q_SA2 = 4.0f;
__device__ __forceinline__ unsigned pk4_fp8(float a, float b, float c, float d) { unsigned r = 0; r = __builtin_amdgcn_cvt_pk_fp8_f32(a, b, r, false); r = __builtin_amdgcn_cvt_pk_fp8_f32(c, d, r, true); return r; }
__device__ __forceinline__ void st16_wt(void* p, u32x4 v) { asm volatile("global_store_dwordx4 %0, %1, off sc1\n\ts_nop 1" :: "v"(p), "v"(v) : "memory"); }

__device__ __forceinline__ void p0_transpose_item(const float* W, int K, int N, bf16* WT, int k0, int n0, int roff, int rmul, LAS float* scr, int lane) {
    float wv_[32];
#pragma unroll
    for (int i = 0; i < 32; ++i) wv_[i] = W[(size_t)(k0 + 2 * i + (lane >> 5)) * N + n0 + (lane & 31)];
#pragma unroll
    for (int i = 0; i < 32; ++i) scr[(2 * i + (lane >> 5)) * 33 + (lane & 31)] = wv_[i];
    asm volatile("s_waitcnt lgkmcnt(0)" ::: "memory");
    const int c = lane & 7;
#pragma unroll
    for (int j = 0; j < 4; ++j) { const int n = (lane >> 3) + 8 * j; const LAS float* s = scr + (8 * c) * 33 + n;
        u32x4 o; o.x = pk2(s[0 * 33], s[1 * 33]); o.y = pk2(s[2 * 33], s[3 * 33]); o.z = pk2(s[4 * 33], s[5 * 33]); o.w = pk2(s[6 * 33], s[7 * 33]);
        *(u32x4*)(WT + (size_t)(roff + n * rmul) * K + k0 + 8 * c) = o; }
    asm volatile("s_waitcnt lgkmcnt(0)" ::: "memory");
}
__device__ __forceinline__ void p0_transpose_item_f8(const float* W, int K, int N, unsigned char* WT, int k0, int n0, int roff, int rmul, LAS float* scr, int lane) {
    float wv_[32];
#pragma unroll
    for (int i = 0; i < 32; ++i) wv_[i] = W[(size_t)(k0 + 2 * i + (lane >> 5)) * N + n0 + (lane & 31)];
#pragma unroll
    for (int i = 0; i < 32; ++i) scr[(2 * i + (lane >> 5)) * 33 + (lane & 31)] = wv_[i];
    asm volatile("s_waitcnt lgkmcnt(0)" ::: "memory");
    const int c = lane & 7;
#pragma unroll
    for (int j = 0; j < 4; ++j) { const int n = (lane >> 3) + 8 * j; const LAS float* s = scr + (8 * c) * 33 + n;
        u32x2 o; o.x = pk4_fp8(s[0 * 33] * Q_SW, s[1 * 33] * Q_SW, s[2 * 33] * Q_SW, s[3 * 33] * Q_SW); o.y = pk4_fp8(s[4 * 33] * Q_SW, s[5 * 33] * Q_SW, s[6 * 33] * Q_SW, s[7 * 33] * Q_SW);
        *(u32x2*)(WT + (size_t)(roff + n * rmul) * K + k0 + 8 * c) = o; }
    asm volatile("s_waitcnt lgkmcnt(0)" ::: "memory");
}

constexpr int XI_A = 64 * 1024, XI_B = 64 * 512, XI_N = XI_A + XI_B;
__device__ __forceinline__ void p0_expert_item(ArgP a, int r, LAS float* scr, int lane) {
    unsigned char* ws = a->ws;
    if (r < XI_A) { const int mi = r >> 10, q = r & 1023, kb = q >> 6, nb = q & 63;
        p0_transpose_item(a->in[I_EW1] + (size_t)mi * 1024 * 2048, 1024, 2048, (bf16*)(ws + WS_EW1) + (size_t)mi * 2048 * 1024, kb * 64, nb * 32, nb * 32, 1, scr, lane); }
    else { r -= XI_A; const int mi = r >> 9, q = r & 511, kb = q >> 5, nb = q & 31;
        p0_transpose_item(a->in[I_EW2] + (size_t)mi * 1024 * 1024, 1024, 1024, (bf16*)(ws + WS_EW2) + (size_t)mi * 1024 * 1024, kb * 64, nb * 32, nb * 32, 1, scr, lane); }
}

__device__ __forceinline__ void p0_prologue(ArgP a, const Ctx& F) {
    unsigned char* ws = a->ws;
    if (F.vcu < 192) {
        LAS float* SC = (LAS float*)F.lds; LAS float* RED = (LAS float*)(F.lds + 17 * 1024 * 4);
        {   float tv[34];
#pragma unroll
            for (int q = 0; q < 34; ++q) tv[q] = q < 32 ? a->in[I_C][F.tid + NTHR * q] : a->in[I_CCTX][F.tid + NTHR * (q - 32)];
#pragma unroll
            for (int q = 0; q < 34; ++q) SC[F.tid + NTHR * q] = tv[q] * sigmoidf_(tv[q]); }
        __syncthreads();
        const int l = F.vcu / 96, jb = F.vcu % 96, j = jb * 64 + F.lane;
        const float* W = a->in[I_ADAW] + (size_t)l * 1024 * 6144 + j;
        float acc[17];
#pragma unroll
        for (int b = 0; b < 17; ++b) acc[b] = 0.f;
        {
            const int kb = F.wave * 128, ke = kb + 128;
            float wA[8], wB[8];
#pragma unroll
            for (int i = 0; i < 8; ++i) { wA[i] = W[(size_t)(kb + i) * 6144]; wB[i] = W[(size_t)(kb + 8 + i) * 6144]; }
#pragma unroll 1
            for (int k = kb; k < ke; k += 16) {
#pragma unroll
                for (int b = 0; b < 17; ++b) { const f32x4 s0 = *(const LAS f32x4*)(SC + b * 1024 + k), s1 = *(const LAS f32x4*)(SC + b * 1024 + k + 4);
                    acc[b] += (s0.x * wA[0] + s0.y * wA[1] + s0.z * wA[2] + s0.w * wA[3]) + (s1.x * wA[4] + s1.y * wA[5] + s1.z * wA[6] + s1.w * wA[7]); if (b == 5 || b == 11) __builtin_amdgcn_sched_barrier(0); }
                { const int kn = (k + 16 < ke) ? k + 16 : kb;
#pragma unroll
                  for (int i = 0; i < 8; ++i) wA[i] = W[(size_t)(kn + i) * 6144]; }
                __builtin_amdgcn_sched_barrier(0);
#pragma unroll
                for (int b = 0; b < 17; ++b) { const f32x4 s0 = *(const LAS f32x4*)(SC + b * 1024 + k + 8), s1 = *(const LAS f32x4*)(SC + b * 1024 + k + 12);
                    acc[b] += (s0.x * wB[0] + s0.y * wB[1] + s0.z * wB[2] + s0.w * wB[3]) + (s1.x * wB[4] + s1.y * wB[5] + s1.z * wB[6] + s1.w * wB[7]); if (b == 5 || b == 11) __builtin_amdgcn_sched_barrier(0); }
                { const int kn = (k + 24 < ke) ? k + 24 : kb;
#pragma unroll
                  for (int i = 0; i < 8; ++i) wB[i] = W[(size_t)(kn + i) * 6144]; }
                __builtin_amdgcn_sched_barrier(0);
            }
        }
#pragma unroll
        for (int b = 0; b < 17; ++b) RED[(F.wave * 17 + b) * 64 + F.lane] = acc[b];
        __syncthreads();
        float* mod = (float*)(ws + WS_MOD);
        for (int idx = F.tid; idx < 17 * 64; idx += NTHR) { const int b = idx >> 6, jl = idx & 63; float s = 0.f;
#pragma unroll
            for (int w = 0; w < 8; ++w) s += RED[(w * 17 + b) * 64 + jl];
            const int jj = jb * 64 + jl; s += a->in[I_ADAB][l * 6144 + jj];
            if (b < 16) mod[(size_t)(l * 16 + b) * 6144 + jj] = s; else if (l == 0) mod[2 * 16 * 6144 + jj] = s; }
        __syncthreads();
    }
    LAS float* scr = (LAS float*)(F.lds + F.wave * 16384);
    const int gw = F.vcu * NWAVES + F.wave, NGW = F.G * NWAVES;
    constexpr int I_A = 64 * 1024, I_B = 64 * 512, I_Cc = 16 * 108, I_D = 512, I_E = 1024, I_F = 512, I_G = 96;
    constexpr int NITEMS = I_A + I_B + I_Cc + I_D + I_E + I_F + I_G;
    for (int it = gw + I_A + I_B; it < NITEMS; it += NGW) {
        int r = it;
        if (r < I_A) { const int mi = r >> 10, q = r & 1023, kb = q >> 6, nb = q & 63;
            p0_transpose_item(a->in[I_EW1] + (size_t)mi * 1024 * 2048, 1024, 2048, (bf16*)(ws + WS_EW1) + (size_t)mi * 2048 * 1024, kb * 64, nb * 32, nb * 32, 1, scr, F.lane); continue; } r -= I_A;
        if (r < I_B) { const int mi = r >> 9, q = r & 511, kb = q >> 5, nb = q & 31;
            p0_transpose_item(a->in[I_EW2] + (size_t)mi * 1024 * 1024, 1024, 1024, (bf16*)(ws + WS_EW2) + (size_t)mi * 1024 * 1024, kb * 64, nb * 32, nb * 32, 1, scr, F.lane); continue; } r -= I_B;
        if (r < I_Cc) { const int kb = r / 108, nb = r % 108, n0 = nb * 32;
            const int roff = n0 < 512 ? n0 : (n0 < 2432 ? 1024 + (n0 - 512) : (n0 < 2944 ? 512 + (n0 - 2432) : 3072 + (n0 - 2944)));
            p0_transpose_item_f8(a->in[I_WIN], 1024, 3456, ws + WS_WIN, kb * 64, n0, roff, 1, scr, F.lane); continue; } r -= I_Cc;
        if (r < I_D) { const int kb = r >> 5, nb = r & 31; p0_transpose_item_f8(a->in[I_WOUT], 1024, 1024, ws + WS_WOUT, kb * 64, nb * 32, nb * 32, 1, scr, F.lane); continue; } r -= I_D;
        if (r < I_E) { const int kb = r >> 6, nb = r & 63, n0 = nb * 32;
            p0_transpose_item_f8(a->in[I_PW1W], 1024, 2048, ws + WS_PW1, kb * 64, n0, n0 < 1024 ? 2 * n0 : 2 * (n0 - 1024) + 1, 2, scr, F.lane); continue; } r -= I_E;
        if (r < I_F) { const int kb = r >> 5, nb = r & 31; p0_transpose_item_f8(a->in[I_PW2W], 1024, 1024, ws + WS_PW2, kb * 64, nb * 32, nb * 32, 1, scr, F.lane); continue; } r -= I_F;
        {   bf16* sw = (bf16*)(ws + WS_SMALLW);
            if (r < 32) { const int kb = r >> 4, nb = r & 15; p0_transpose_item(a->in[I_G2], 128, 512, sw, kb * 64, nb * 32, nb * 32, 1, scr, F.lane); }
            else if (r < 64) { const int q = r - 32, d = q >> 4, nb = q & 15; p0_transpose_item(a->in[I_W2] + d * 64 * 512, 64, 512, sw + 65536 + d * 32768, 0, nb * 32, nb * 32, 1, scr, F.lane); }
            else { const int q = r - 64, d = q >> 4, nb = q & 15; p0_transpose_item(a->in[I_A2] + d * 64 * 512, 64, 512, sw + 131072 + d * 32768, 0, nb * 32, nb * 32, 1, scr, F.lane); } }
    }
    const int gt = F.vcu * NTHR + F.tid, NGT = F.G * NTHR;
    for (int i = gt; i < 128 * 1024 / 16; i += NGT) ((u32x4*)(ws + WS_WIN + (size_t)2944 * 1024))[i] = (u32x4){0u, 0u, 0u, 0u};
    float* rwt = (float*)(ws + WS_SMALLW + 393216);
    for (int i = gt; i < 2 * 32 * 1024; i += NGT) { const int l = i >> 15, e = (i >> 10) & 31, k = i & 1023; rwt[i] = a->in[I_RW][(size_t)(l * 1024 + k) * 32 + e]; }
}

__device__ __forceinline__ void row_load(const float* p, int lane, f32x4 (&v)[4]) {
#pragma unroll
    for (int j = 0; j < 4; ++j) v[j] = ((const f32x4*)p)[lane + 64 * j];
}
__device__ __forceinline__ void row_load_b16(const bf16* p, int lane, f32x4 (&v)[4]) {
#pragma unroll
    for (int j = 0; j < 4; ++j) { const u32x2 u = ((const u32x2*)p)[lane + 64 * j]; v[j] = (f32x4){bflo(u.x), bfhi(u.x), bflo(u.y), bfhi(u.y)}; }
}
__device__ __forceinline__ float row_rstd(const f32x4 (&v)[4]) {
    float s = 0.f;
#pragma unroll
    for (int j = 0; j < 4; ++j) s += (v[j].x * v[j].x + v[j].y * v[j].y) + (v[j].z * v[j].z + v[j].w * v[j].w);
    return __frsqrt_rn(wave_sum(s) * (1.0f / D) + 1e-6f);
}
__device__ __forceinline__ void row_adaln(f32x4 (&v)[4], const float* g, const float* shift, const float* scale, int lane) {
    const float rs = row_rstd(v);
#pragma unroll
    for (int j = 0; j < 4; ++j) { const f32x4 gg = ((const f32x4*)g)[lane + 64 * j], sh = ((const f32x4*)shift)[lane + 64 * j], sc = ((const f32x4*)scale)[lane + 64 * j];
        v[j] = (v[j] * rs) * gg * (sc + 1.0f) + sh; }
}
__device__ __forceinline__ void row_store_fp8_wt(unsigned char* p, int lane, const f32x4 (&v)[4], float scale) {
    unsigned u[4];
#pragma unroll
    for (int j = 0; j < 4; ++j) u[j] = pk4_fp8(v[j].x * scale, v[j].y * scale, v[j].z * scale, v[j].w * scale);
    const bool b0 = lane & 1, b1 = lane & 2;
    const unsigned r0 = (unsigned)__shfl_xor((int)(b0 ? u[0] : u[1]), 1), r1 = (unsigned)__shfl_xor((int)(b0 ? u[2] : u[3]), 1);
    const unsigned ax = b0 ? r0 : u[0], ay = b0 ? u[1] : r0, bx = b0 ? r1 : u[2], by = b0 ? u[3] : r1;
    const unsigned t0 = (unsigned)__shfl_xor((int)(b1 ? ax : bx), 2), t1 = (unsigned)__shfl_xor((int)(b1 ? ay : by), 2);
    const u32x4 o = b1 ? (u32x4){t0, t1, bx, by} : (u32x4){ax, ay, t0, t1};
    st16_wt(p + 256 * (lane & 3) + 4 * (lane & ~3), o);
}
__device__ __forceinline__ void row_store_bf16_wt(bf16* p, int lane, const f32x4 (&v)[4]) {
    u32x2 u[4];
#pragma unroll
    for (int j = 0; j < 4; ++j) { u[j].x = pk2(v[j].x, v[j].y); u[j].y = pk2(v[j].z, v[j].w); }
    const bool b0 = lane & 1;
    u32x2 ra, rb;
    ra.x = (unsigned)__shfl_xor((int)(b0 ? u[0].x : u[1].x), 1); ra.y = (unsigned)__shfl_xor((int)(b0 ? u[0].y : u[1].y), 1);
    rb.x = (unsigned)__shfl_xor((int)(b0 ? u[2].x : u[3].x), 1); rb.y = (unsigned)__shfl_xor((int)(b0 ? u[2].y : u[3].y), 1);
    const u32x4 oa = b0 ? (u32x4){ra.x, ra.y, u[1].x, u[1].y} : (u32x4){u[0].x, u[0].y, ra.x, ra.y};
    const u32x4 ob = b0 ? (u32x4){rb.x, rb.y, u[3].x, u[3].y} : (u32x4){u[2].x, u[2].y, rb.x, rb.y};
    bf16* q = p + 256 * (lane & 1) + 4 * (lane & ~1);
    st16_wt(q, oa); st16_wt(q + 512, ob);
}
__device__ __forceinline__ void row_store_bf16(bf16* p, int lane, const f32x4 (&v)[4]) {
#pragma unroll
    for (int j = 0; j < 4; ++j) { u32x2 o; o.x = pk2(v[j].x, v[j].y); o.y = pk2(v[j].z, v[j].w); ((u32x2*)p)[lane + 64 * j] = o; }
}

__device__ __forceinline__ void p1_adaln0(ArgP a, const Ctx& F) {
    const float* mod = (const float*)(a->ws + WS_MOD); const float* modc = mod + 2 * 16 * 6144;
    bf16* H = (bf16*)(a->ws + WS_H);
    const int gw = F.vcu * NWAVES + F.wave, NGW = F.G * NWAVES;
    for (int rowr = gw; rowr < MROWS * PROBE_R_ADALN; rowr += NGW) { const int row = rowr % MROWS;
        f32x4 v[4];
        if (row < NTOK) { row_load(a->in[I_X] + (size_t)row * D, F.lane, v); const float* m = mod + (size_t)(row >> 11) * 6144; row_adaln(v, a->in[I_NMIXG], m, m + 1024, F.lane); }
        else { row_load(a->in[I_CTX] + (size_t)(row - NTOK) * D, F.lane, v); row_adaln(v, a->in[I_NMIXG], modc, modc + 1024, F.lane); }
        row_store_fp8_wt((unsigned char*)H + (size_t)row * D, F.lane, v, Q_SA);
    }
}

typedef f32x4 AccT[2][2][4][2];

constexpr int EPI_TP = 8 * pg8::HTB, EPI_TPS = 40;
struct EpiInproj {
    static constexpr bool PERM = true, WIDE = true;
    bf16* P; bf16* VT; bf16* KB; LAS unsigned char* lds;
    struct Pre {}; __device__ __forceinline__ Pre pre(const pg8::Unit&, int, int) const { return Pre{}; }
    __device__ __forceinline__ void operator()(const AccT& acc, const pg8::Unit& u, int wr, int wc, int fr, int fq, const Pre&) const {
        { const int ln = lane_id(); fr = ln & 15; fq = ln >> 4; }
        if (u.pn < 2 || (u.pn >= 4 && u.pn < 12)) {
            const float sc = ((u.pn < 2) ? 0.125f : 1.0f) * (1.0f / (Q_SA * Q_SW));
            const bool hb = fr >= 8;
            bf16* ob = P + (size_t)(u.pm * 256 + wr * 64 + (fr & 7)) * PW + u.pn * 256 + wc * 64 + 8 * fq + (hb ? 32 : 0);
#pragma unroll
            for (int ai = 0; ai < 2; ++ai)
#pragma unroll
                for (int m = 0; m < 4; ++m) { u32x4 w[2];
#pragma unroll
                    for (int bj = 0; bj < 2; ++bj) { const f32x4 v0 = acc[ai][bj][m][0] * sc, v1 = acc[ai][bj][m][1] * sc;
                        w[bj].x = pg8::cvt_pk_bf16(v0[0], v0[1]); w[bj].y = pg8::cvt_pk_bf16(v0[2], v0[3]); w[bj].z = pg8::cvt_pk_bf16(v1[0], v1[1]); w[bj].w = pg8::cvt_pk_bf16(v1[2], v1[3]); }
                    u32x4 s1, s2;
#pragma unroll
                    for (int q = 0; q < 4; ++q) { const unsigned give = hb ? w[0][q] : w[1][q]; const unsigned recv = (unsigned)__shfl_xor((int)give, 8); s1[q] = hb ? recv : w[0][q]; s2[q] = hb ? w[1][q] : recv; }
                    bf16* op = ob + (size_t)(ai * 128 + m * 16) * PW;
                    st16_wt(op, s1); st16_wt(op + 8 * PW, s2);
                    __builtin_amdgcn_sched_barrier(0); }
        } else if (u.pn < 4) {
            const int row0 = u.pm * 256 + wr * 64 + fr;
#pragma unroll
            for (int ai = 0; ai < 2; ++ai)
#pragma unroll
                for (int m = 0; m < 4; ++m) { const int row = row0 + ai * 128 + m * 16; int b, pos;
                    if (row < NTOK) { b = row >> 11; pos = CTXL + (row & 2047); } else { const int rr = row - NTOK; b = rr >> 8; pos = rr & 255; }
                    const int hd = (u.pn - 2) * 4 + wc;
#pragma unroll
                    for (int bj = 0; bj < 2; ++bj) {
                        const f32x4 v0 = acc[ai][bj][m][0] * (1.0f / (Q_SA * Q_SW)), v1 = acc[ai][bj][m][1] * (1.0f / (Q_SA * Q_SW));
                        u32x4 w; w.x = pg8::cvt_pk_bf16(v0[0], v0[1]); w.y = pg8::cvt_pk_bf16(v0[2], v0[3]); w.z = pg8::cvt_pk_bf16(v1[0], v1[1]); w.w = pg8::cvt_pk_bf16(v1[2], v1[3]);
                        st16_wt(KB + (size_t)(b * 8 + hd) * TT * 64 + (size_t)(((((pos >> 3) * 2 + bj) * 4 + fq) * 8 + (pos & 7)) * 8), w); }
                    __builtin_amdgcn_sched_barrier(0); }
        } else {
            LAS unsigned char* tp = lds + EPI_TP + (wr * 4 + wc) * (32 * EPI_TPS);
            const int lane = fq * 16 + fr, dl = lane >> 1, hb = lane & 1;
            const int hd = (u.pn - 12) * 4 + wc;
#pragma unroll
            for (int ai = 0; ai < 2; ++ai)
#pragma unroll
                for (int m = 0; m < 4; ++m) { const int rowa = u.pm * 256 + wr * 64 + ai * 128 + m * 16; int b, pos0;
                    if (rowa < NTOK) { b = rowa >> 11; pos0 = CTXL + (rowa & 2047); } else { const int rr = rowa - NTOK; b = rr >> 8; pos0 = rr & 255; }
#pragma unroll
                    for (int bj = 0; bj < 2; ++bj) {
#pragma unroll
                        for (int n = 0; n < 2; ++n)
#pragma unroll
                            for (int j = 0; j < 4; ++j) *(LAS bf16*)(tp + (8 * fq + 4 * n + j) * EPI_TPS + fr * 2) = (bf16)f2bf(acc[ai][bj][m][n][j] * (1.0f / (Q_SA * Q_SW)));
                        const u32x2 lo = *(const LAS u32x2*)(tp + dl * EPI_TPS + hb * 16), hi = *(const LAS u32x2*)(tp + dl * EPI_TPS + hb * 16 + 8);
                        st16_wt(VT + (size_t)(b * 8 + hd) * TT * 64 + (size_t)((((pos0 >> 3) + hb) * 64 + bj * 32 + dl) * 8), (u32x4){lo.x, lo.y, hi.x, hi.y}); }
                    __builtin_amdgcn_sched_barrier(0); }
        }
    }
};

template <bool BASE16> struct EpiResid {
    static constexpr bool PERM = true, WIDE = true;
    const void* base; bf16* out; const float* gate; const float* bias;
    struct Pre { f32x4 g[2][2], bs[2][2]; };
    __device__ __forceinline__ Pre pre(const pg8::Unit& u, int wr, int wc) const { const int fq = lane_id() >> 4; const int cb = u.pn * 256 + wc * 64 + 8 * fq;
        const float* gp = gate + (size_t)((u.pm * 256) >> 11) * 6144;
        Pre p;
#pragma unroll
        for (int bj = 0; bj < 2; ++bj) { const int c = cb + 32 * bj; p.g[bj][0] = *(const f32x4*)(gp + c); p.g[bj][1] = *(const f32x4*)(gp + c + 4);
            p.bs[bj][0] = (f32x4){0.f, 0.f, 0.f, 0.f}; p.bs[bj][1] = p.bs[bj][0]; if (bias) { p.bs[bj][0] = *(const f32x4*)(bias + c); p.bs[bj][1] = *(const f32x4*)(bias + c + 4); } }
        return p; }
    struct BaseW { u32x4 h[2]; f32x4 f[2][2]; };
    __device__ __forceinline__ BaseW ldbase(size_t ro, int cb) const { BaseW w;
#pragma unroll
        for (int bj = 0; bj < 2; ++bj) { const int c = cb + 32 * bj;
            if (BASE16) w.h[bj] = *(const u32x4*)((const bf16*)base + ro + c);
            else { w.f[bj][0] = *(const f32x4*)((const float*)base + ro + c); w.f[bj][1] = *(const f32x4*)((const float*)base + ro + c + 4); } }
        return w; }
    __device__ __forceinline__ void operator()(const AccT& acc, const pg8::Unit& u, int wr, int wc, int fr, int fq, const Pre& pre) const {
        { const int ln = lane_id(); fr = ln & 15; fq = ln >> 4; }
        const bool hb = fr >= 8; const int cb = u.pn * 256 + wc * 64 + 8 * fq;
        const int row0 = u.pm * 256 + wr * 64;
        BaseW nx = ldbase((size_t)(row0 + fr) * D, cb);
#pragma unroll
        for (int ai = 0; ai < 2; ++ai)
#pragma unroll
            for (int m = 0; m < 4; ++m) { const int rowg = row0 + ai * 128 + m * 16;
                const BaseW cur = nx;
                { const int gi = ai * 4 + m + 1; if (gi < 8) nx = ldbase((size_t)(row0 + (gi >> 2) * 128 + (gi & 3) * 16 + fr) * D, cb); }
                u32x4 w[2];
#pragma unroll
                for (int bj = 0; bj < 2; ++bj) {
                    constexpr float dq = 1.0f / (Q_SA * Q_SW);
                    const f32x4 v0 = acc[ai][bj][m][0] * dq + pre.bs[bj][0], v1 = acc[ai][bj][m][1] * dq + pre.bs[bj][1];
                    f32x4 x0, x1;
                    if (BASE16) { const u32x4 xb = cur.h[bj]; x0 = (f32x4){bflo(xb.x), bfhi(xb.x), bflo(xb.y), bfhi(xb.y)}; x1 = (f32x4){bflo(xb.z), bfhi(xb.z), bflo(xb.w), bfhi(xb.w)}; }
                    else { x0 = cur.f[bj][0]; x1 = cur.f[bj][1]; }
                    const f32x4 r0 = x0 + pre.g[bj][0] * v0, r1 = x1 + pre.g[bj][1] * v1;
                    w[bj].x = pg8::cvt_pk_bf16(r0[0], r0[1]); w[bj].y = pg8::cvt_pk_bf16(r0[2], r0[3]); w[bj].z = pg8::cvt_pk_bf16(r1[0], r1[1]); w[bj].w = pg8::cvt_pk_bf16(r1[2], r1[3]); }
                u32x4 s1, s2;
#pragma unroll
                for (int q = 0; q < 4; ++q) { const unsigned give = hb ? w[0][q] : w[1][q]; const unsigned recv = (unsigned)__shfl_xor((int)give, 8); s1[q] = hb ? recv : w[0][q]; s2[q] = hb ? w[1][q] : recv; }
                bf16* op = out + (size_t)(rowg + (fr & 7)) * D + cb + (hb ? 32 : 0);
                st16_wt(op, s1); st16_wt(op + 8 * D, s2);
                __builtin_amdgcn_sched_barrier(0); }
    }
};

template <int MODE> struct EpiPair {
    static constexpr bool PERM = true, WIDE = true;
    bf16* O; const float* bias; const int* tile_e;
    struct Pre { f32x4 x[2]; };
    __device__ __forceinline__ void ldbias(const pg8::Unit& u, int c0, f32x4 (&x)[2]) const { const float* bp = bias; if (MODE == 0) bp += (size_t)u.e * 2048;
        if (MODE == 0) { x[0] = *(const f32x4*)(bp + c0); x[1] = *(const f32x4*)(bp + c0 + 4); } else { x[0] = *(const f32x4*)(bp + (c0 >> 1)); x[1] = *(const f32x4*)(bp + 1024 + (c0 >> 1)); } }
    __device__ __forceinline__ Pre pre(const pg8::Unit& u, int wr, int wc) const { Pre p; ldbias(u, u.pn * 256 + wc * 64 + 8 * (lane_id() >> 4), p.x); return p; }
    __device__ __forceinline__ void operator()(const AccT& acc, const pg8::Unit& u, int wr, int wc, int fr, int fq, const Pre& pre) const {
        { const int ln = lane_id(); fr = ln & 15; fq = ln >> 4; }
        const bool hb = fr >= 8; const int cb = u.pn * 256 + wc * 64 + 8 * fq;
        unsigned st8[2][4]; u32x2 st16[2][4];
        f32x4 xb1[2];
#pragma unroll
        for (int bj = 0; bj < 2; ++bj) {
            const f32x4 xa0 = bj == 0 ? pre.x[0] : xb1[0], xa1 = bj == 0 ? pre.x[1] : xb1[1];
            float bg[4], bl[4];
            if (MODE == 0) { bg[0] = xa0[0]; bl[0] = xa0[1]; bg[1] = xa0[2]; bl[1] = xa0[3]; bg[2] = xa1[0]; bl[2] = xa1[1]; bg[3] = xa1[2]; bl[3] = xa1[3]; }
            else {
#pragma unroll
                for (int p = 0; p < 4; ++p) { bg[p] = xa0[p]; bl[p] = xa1[p]; } }
#pragma unroll
            for (int ai = 0; ai < 2; ++ai)
#pragma unroll
                for (int m = 0; m < 4; ++m) {
                    if (bj == 0 && ai == 1 && m == 0) ldbias(u, cb + 32, xb1);
                    constexpr float dq = 1.0f / (Q_SA * Q_SW);
                    const f32x4 v0 = acc[ai][bj][m][0], v1 = acc[ai][bj][m][1];
                    const float e[4] = {__builtin_fmaf(v0[0], dq, bg[0]), __builtin_fmaf(v0[2], dq, bg[1]), __builtin_fmaf(v1[0], dq, bg[2]), __builtin_fmaf(v1[2], dq, bg[3])};
                    const float o[4] = {__builtin_fmaf(v0[1], dq, bl[0]), __builtin_fmaf(v0[3], dq, bl[1]), __builtin_fmaf(v1[1], dq, bl[2]), __builtin_fmaf(v1[3], dq, bl[3])};
                    float r[4];
#pragma unroll
                    for (int p = 0; p < 4; ++p) {
                        if (MODE == 0) { const float gl = fminf(e[p], 7.0f);
                            const float q = __builtin_amdgcn_rcpf(1.0f + __builtin_amdgcn_exp2f(gl * (-1.702f * 1.44269504089f)));
                            r[p] = (gl * q) * __builtin_fmaf(__builtin_amdgcn_fmed3f(o[p], -7.0f, 7.0f), Q_SA2, Q_SA2); }
                        else r[p] = e[p] * sigmoidf_(o[p]); }
                    if (MODE == 0) { const unsigned w = pk4_fp8(r[0], r[1], r[2], r[3]);
                        if (bj == 0) st8[ai][m] = w;
                        else { const unsigned w0 = st8[ai][m], give = hb ? w0 : w, recv = (unsigned)__shfl_xor((int)give, 8);
                            unsigned char* op = (unsigned char*)O + (size_t)(u.pm * 256 + wr * 64 + ai * 128 + m * 16 + (fr & 7)) * D + (cb >> 1) + (hb ? 16 : 0);
                            *(unsigned*)op = hb ? recv : w0; *(unsigned*)(op + 8 * D) = hb ? w : recv; } }
                    else { u32x2 w; w.x = pg8::cvt_pk_bf16(r[0], r[1]); w.y = pg8::cvt_pk_bf16(r[2], r[3]);
                        if (bj == 0) st16[ai][m] = w;
                        else { const u32x2 w0 = st16[ai][m]; u32x2 s1, s2;
#pragma unroll
                            for (int q = 0; q < 2; ++q) { const unsigned give = hb ? w0[q] : w[q], recv = (unsigned)__shfl_xor((int)give, 8); s1[q] = hb ? recv : w0[q]; s2[q] = hb ? w[q] : recv; }
                            bf16* op = O + (size_t)(u.pm * 256 + wr * 64 + ai * 128 + m * 16 + (fr & 7)) * D + (cb >> 1) + (hb ? 16 : 0);
                            *(u32x2*)op = s1; *(u32x2*)(op + 8 * D) = s2; } }
                    __builtin_amdgcn_sched_barrier(0); }
        }
    }
};

struct EpiMoe2 {
    static constexpr bool PERM = true, WIDE = true;
    bf16* O; const float* bias; const int* tile_e;
    struct Pre { f32x4 bv[2][2]; };
    __device__ __forceinline__ Pre pre(const pg8::Unit& u, int wr, int wc) const { const int fq = lane_id() >> 4; const float* bp = bias + (size_t)u.e * 1024 + u.pn * 256 + wc * 64 + 8 * fq; Pre p;
#pragma unroll
        for (int bj = 0; bj < 2; ++bj) { p.bv[bj][0] = *(const f32x4*)(bp + 32 * bj); p.bv[bj][1] = *(const f32x4*)(bp + 32 * bj + 4); }
        return p; }
    __device__ __forceinline__ void operator()(const AccT& acc, const pg8::Unit& u, int wr, int wc, int fr, int fq, const Pre& pre) const {
        const int rlo = fr & 7, hb = fr >> 3, cb = u.pn * 256 + wc * 64 + 8 * fq;
        const f32x4 (&bv)[2][2] = pre.bv;
#pragma unroll
        for (int ai = 0; ai < 2; ++ai)
#pragma unroll
            for (int m = 0; m < 4; ++m) { bf16* rowp = O + (size_t)(u.pm * 256 + wr * 64 + ai * 128 + m * 16 + rlo) * D + cb + 32 * hb;
                constexpr float dq = 1.0f / (Q_SA2 * Q_SW);
                u32x4 w[2];
#pragma unroll
                for (int bj = 0; bj < 2; ++bj) { const f32x4 v0 = acc[ai][bj][m][0] * dq + bv[bj][0], v1 = acc[ai][bj][m][1] * dq + bv[bj][1];
                    w[bj].x = pg8::cvt_pk_bf16(v0[0], v0[1]); w[bj].y = pg8::cvt_pk_bf16(v0[2], v0[3]); w[bj].z = pg8::cvt_pk_bf16(v1[0], v1[1]); w[bj].w = pg8::cvt_pk_bf16(v1[2], v1[3]); }
                u32x4 s1, s2;
#pragma unroll
                for (int q = 0; q < 4; ++q) { const unsigned give = hb ? w[0][q] : w[1][q]; const unsigned recv = (unsigned)__shfl_xor((int)give, 8); s1[q] = hb ? recv : w[0][q]; s2[q] = hb ? w[1][q] : recv; }
                st16_wt(rowp, s1); st16_wt(rowp + 8 * D, s2);
                __builtin_amdgcn_sched_barrier(0); }
    }
};

__device__ __forceinline__ float xrow16_sum(float x) {
    auto s = __builtin_amdgcn_permlane16_swap(__float_as_uint(x), __float_as_uint(x), false, false);
    x = __uint_as_float(s[0]) + __uint_as_float(s[1]);
    auto t = __builtin_amdgcn_permlane32_swap(__float_as_uint(x), __float_as_uint(x), false, false);
    return __uint_as_float(t[0]) + __uint_as_float(t[1]);
}
constexpr int XLS = 392;
__device__ __forceinline__ void shift8(const bf16* pr, int pc, bool hasp, bool hasn, const float* mup, const float* mun, float (&s)[8]) {
    const u32x4 c = *(const u32x4*)(pr + pc);
    u32x4 p = (u32x4){0u, 0u, 0u, 0u}, n = (u32x4){0u, 0u, 0u, 0u};
    if (hasp) p = *(const u32x4*)(pr - PW + pc);
    if (hasn) n = *(const u32x4*)(pr + PW + pc);
    const int mi = pc - 1024;
    const f32x4 mp0 = *(const f32x4*)(mup + mi), mp1 = *(const f32x4*)(mup + mi + 4), mn0 = *(const f32x4*)(mun + mi), mn1 = *(const f32x4*)(mun + mi + 4);
#pragma unroll
    for (int q = 0; q < 4; ++q) {
        const float c0 = bflo(c[q]), c1 = bfhi(c[q]), p0 = bflo(p[q]), p1 = bfhi(p[q]), n0 = bflo(n[q]), n1 = bfhi(n[q]);
        const float a0 = q < 2 ? mp0[2 * q] : mp1[2 * q - 4], a1 = q < 2 ? mp0[2 * q + 1] : mp1[2 * q - 3];
        const float b0 = q < 2 ? mn0[2 * q] : mn1[2 * q - 4], b1 = q < 2 ? mn0[2 * q + 1] : mn1[2 * q - 3];
        s[2 * q] = c0 + a0 * (p0 - c0) + b0 * (n0 - c0); s[2 * q + 1] = c1 + a1 * (p1 - c1) + b1 * (n1 - c1);
    }
}
__device__ __forceinline__ void shift4(const bf16* pr, int pc, bool hasp, bool hasn, const float* mup, const float* mun, float (&s)[4]) {
    const u32x2 c = *(const u32x2*)(pr + pc);
    u32x2 p = (u32x2){0u, 0u}, n = (u32x2){0u, 0u};
    if (hasp) p = *(const u32x2*)(pr - PW + pc);
    if (hasn) n = *(const u32x2*)(pr + PW + pc);
    const int mi = pc - 1024;
    const f32x4 mp = *(const f32x4*)(mup + mi), mn = *(const f32x4*)(mun + mi);
#pragma unroll
    for (int q = 0; q < 2; ++q) {
        const float c0 = bflo(c[q]), c1 = bfhi(c[q]), p0 = bflo(p[q]), p1 = bfhi(p[q]), n0 = bflo(n[q]), n1 = bfhi(n[q]);
        s[2 * q] = c0 + mp[2 * q] * (p0 - c0) + mn[2 * q] * (n0 - c0); s[2 * q + 1] = c1 + mp[2 * q + 1] * (p1 - c1) + mn[2 * q + 1] * (n1 - c1);
    }
}


constexpr int SQ_STEPS = 16, SQ_NSUB = TT / SQ_STEPS, SQ_BLKB = 1840, SQ_SLOTB = 8 * SQ_BLKB, SQ_NSLOT = 6;
constexpr int SQ_RING = 0, SQ_FLAG = SQ_NSLOT * SQ_SLOTB, SQ_XL = SQ_FLAG + 64, SQ_XLS = 264, SQ_XLW = 16 * SQ_XLS * 2;
constexpr int MUK = 0, MUV = 64, MUR = 128, MUW = 192, MUA = 256, MUG = 320, MUN = 448;
constexpr int SQ_NPROD = 5;
constexpr int SQ_MU = SQ_XL + SQ_NPROD * SQ_XLW, SQ_PAR = SQ_MU + 2 * MUN * 4, SQ_WL = SQ_PAR + 5 * 64 * 4;
constexpr int WLS2 = 72, WLSG = 136;
constexpr int SQ_WLD = SQ_WL, SQ_WLI = SQ_WLD + 64 * WLS2 * 2, SQ_END = SQ_WLI + 64 * WLS2 * 2;
constexpr int SQ_ZRB = (SQ_END + 15) & ~15;
static_assert(SQ_ZRB + 512 <= LDSCTL_OFF, "scan LDS map (zero block)");
static_assert(SQ_END <= LDSCTL_OFF && SQ_XL % 16 == 0 && SQ_MU % 16 == 0 && SQ_WL % 16 == 0, "scan LDS map");

constexpr int BG_GROUPS = 64 * 8 * 8 + 64 * 8 * 4, BG_SUB = 16, BG_ROWS = 8;
struct BgJob { const float* src; unsigned char* dst; int N; };
__device__ __forceinline__ BgJob bg_job(ArgP a, int grp, int kbl, int lane) {
    const float* W; unsigned char* WT; int N, nb, kh;
    if (grp < 4096) { const int mi = grp >> 6; kh = (grp >> 3) & 7; nb = grp & 7; N = 2048; W = a->in[I_EW1] + (size_t)mi * 1024 * 2048; WT = a->ws + WS_EW1 + (size_t)mi * 2048 * 1024; }
    else { const int q = grp - 4096, mi = q >> 5; kh = (q >> 2) & 7; nb = q & 3; N = 1024; W = a->in[I_EW2] + (size_t)mi * 1024 * 1024; WT = a->ws + WS_EW2 + (size_t)mi * 1024 * 1024; }
    const int k0 = kh * 128 + BG_ROWS * (lane & 15), n = nb * 256 + 16 * kbl + 4 * (lane >> 4);
    BgJob j; j.src = W + (size_t)k0 * N + n; j.dst = WT + (size_t)n * 1024 + k0; j.N = N; return j;
}
__device__ __forceinline__ void bg_issue(const BgJob& j, f32x4 (&v)[BG_ROWS]) {
#pragma unroll
    for (int i = 0; i < BG_ROWS; ++i) v[i] = *(const f32x4*)(j.src + (size_t)i * j.N);
}
__device__ __forceinline__ void bg_finish(const BgJob& j, const f32x4 (&v)[BG_ROWS]) {
#pragma unroll
    for (int q = 0; q < 4; ++q) { u32x2 o;
        o.x = pk4_fp8(v[0][q] * Q_SW, v[1][q] * Q_SW, v[2][q] * Q_SW, v[3][q] * Q_SW); o.y = pk4_fp8(v[4][q] * Q_SW, v[5][q] * Q_SW, v[6][q] * Q_SW, v[7][q] * Q_SW);
        *(u32x2*)(j.dst + (size_t)q * 1024) = o; }
}

struct Raw4 { u32x2 c, p, n; };
struct Raw8 { u32x4 c, p, n; };
__device__ __forceinline__ Raw4 raw4_load(const bf16* pr, int pc, bool hasp, bool hasn) { Raw4 r; r.c = *(const u32x2*)(pr + pc); r.p = (u32x2){0u, 0u}; r.n = (u32x2){0u, 0u};
    if (hasp) r.p = *(const u32x2*)(pr - PW + pc); if (hasn) r.n = *(const u32x2*)(pr + PW + pc); return r; }
__device__ __forceinline__ Raw8 raw8_load(const bf16* pr, int pc, bool hasp, bool hasn) { Raw8 r; r.c = *(const u32x4*)(pr + pc); r.p = (u32x4){0u, 0u, 0u, 0u}; r.n = (u32x4){0u, 0u, 0u, 0u};
    if (hasp) r.p = *(const u32x4*)(pr - PW + pc); if (hasn) r.n = *(const u32x4*)(pr + PW + pc); return r; }
__device__ __forceinline__ void shift4_raw(const Raw4& r, int mi, const LAS float* MU, float (&s)[4]) {
    const f32x4 mp = *(const LAS f32x4*)(MU + mi), mn = *(const LAS f32x4*)(MU + MUN + mi);
#pragma unroll
    for (int q = 0; q < 2; ++q) { const float c0 = bflo(r.c[q]), c1 = bfhi(r.c[q]);
        s[2 * q] = c0 + mp[2 * q] * (bflo(r.p[q]) - c0) + mn[2 * q] * (bflo(r.n[q]) - c0); s[2 * q + 1] = c1 + mp[2 * q + 1] * (bfhi(r.p[q]) - c1) + mn[2 * q + 1] * (bfhi(r.n[q]) - c1); }
}
__device__ __forceinline__ void shift8_raw(const Raw8& r, int mi, const LAS float* MU, float (&s)[8]) {
    const f32x4 mp0 = *(const LAS f32x4*)(MU + mi), mp1 = *(const LAS f32x4*)(MU + mi + 4), mn0 = *(const LAS f32x4*)(MU + MUN + mi), mn1 = *(const LAS f32x4*)(MU + MUN + mi + 4);
#pragma unroll
    for (int q = 0; q < 4; ++q) { const float c0 = bflo(r.c[q]), c1 = bfhi(r.c[q]);
        const float a0 = q < 2 ? mp0[2 * q] : mp1[2 * q - 4], a1 = q < 2 ? mp0[2 * q + 1] : mp1[2 * q - 3], b0 = q < 2 ? mn0[2 * q] : mn1[2 * q - 4], b1 = q < 2 ? mn0[2 * q + 1] : mn1[2 * q - 3];
        s[2 * q] = c0 + a0 * (bflo(r.p[q]) - c0) + b0 * (bflo(r.n[q]) - c0); s[2 * q + 1] = c1 + a1 * (bfhi(r.p[q]) - c1) + b1 * (bfhi(r.n[q]) - c1); }
}

__device__ __forceinline__ void scan_produce(ArgP a, LAS unsigned char* lds, int dir, int b, int h, int sc, int lw, int lane) {
    asm volatile("" : "+v"(lane));
    unsigned char* ws = a->ws;
    const bf16* P = (const bf16*)(ws + WS_P);
    const LAS bf16* WLD = (const LAS bf16*)(lds + SQ_WLD); const LAS bf16* WLI = (const LAS bf16*)(lds + SQ_WLI); const bf16* G2H = (const bf16*)(a->ws + WS_SMALLW) + 64 * h * 128;
    const LAS float* MU = (const LAS float*)(lds + SQ_MU); const LAS float* PAR = (const LAS float*)(lds + SQ_PAR);
    LAS bf16* XL = (LAS bf16*)(lds + SQ_XL + lw * SQ_XLW);
    const int sq = sc % SQ_NSLOT; LAS unsigned char* slot = lds + SQ_RING + sq * SQ_SLOTB;
    const int s0 = sc * SQ_STEPS; const bool is_ctx = s0 < CTXL; const int L = is_ctx ? CTXL : T, rowbase = is_ctx ? NTOK + b * CTXL : b * T;
    const int tlo = dir == 0 ? (is_ctx ? s0 : s0 - CTXL) : (is_ctx ? CTXL - 16 - s0 : T - 16 - (s0 - CTXL));
    const int g = lane >> 4, n = lane & 15;
    const bool do_g = !is_ctx && ((tlo >= T / 2) == (dir != 0));
    const int t = tlo + n, sl = dir == 0 ? n : 15 - n;
    const bf16* pr = P + (size_t)(rowbase + t) * PW; const bool hp = t > 0, hn = t < L - 1;
    Raw4 rk_[4], rv_[4], rr_[4];
#pragma unroll
    for (int ct = 0; ct < 4; ++ct) { const int co = 64 * h + 16 * ct + 4 * g; rk_[ct] = raw4_load(pr, PC_KA + co, hp, hn); rv_[ct] = raw4_load(pr, PC_VA + co, hp, hn); rr_[ct] = raw4_load(pr, PC_RA + co, hp, hn); }
    {   const int tl = lane >> 2, sub = lane & 3, t1 = tlo + tl;
        const bf16* p1 = P + (size_t)(rowbase + t1) * PW; const bool hp1 = t1 > 0, hn1 = t1 < L - 1;
        Raw8 rw[2], ra[2];
#pragma unroll
        for (int q = 0; q < 2; ++q) { rw[q] = raw8_load(p1, PC_WD + 64 * dir + 16 * sub + 8 * q, hp1, hn1); ra[q] = raw8_load(p1, PC_AD + 64 * dir + 16 * sub + 8 * q, hp1, hn1); }
#pragma unroll
        for (int q = 0; q < 2; ++q) {
            float s[8]; shift8_raw(rw[q], MUW + 16 * sub + 8 * q, MU, s);
#pragma unroll
            for (int i = 0; i < 8; ++i) { const float e = __expf(2.0f * s[i]); s[i] = 1.0f - 2.0f * __builtin_amdgcn_rcpf(e + 1.0f); }
            u32x4 o; o.x = pk2(s[0], s[1]); o.y = pk2(s[2], s[3]); o.z = pk2(s[4], s[5]); o.w = pk2(s[6], s[7]);
            *(LAS u32x4*)(XL + tl * SQ_XLS + 16 * sub + 8 * q) = o;
            shift8_raw(ra[q], MUA + 16 * sub + 8 * q, MU, s);
            o.x = pk2(s[0], s[1]); o.y = pk2(s[2], s[3]); o.z = pk2(s[4], s[5]); o.w = pk2(s[6], s[7]);
            *(LAS u32x4*)(XL + tl * SQ_XLS + 64 + 16 * sub + 8 * q) = o;
        }
        if (do_g) {
            Raw8 rg[4];
#pragma unroll
            for (int q = 0; q < 4; ++q) rg[q] = raw8_load(p1, PC_GD + 32 * sub + 8 * q, hp1, hn1);
#pragma unroll
            for (int q = 0; q < 4; ++q) {
                float s[8]; shift8_raw(rg[q], MUG + 32 * sub + 8 * q, MU, s);
#pragma unroll
                for (int i = 0; i < 8; ++i) s[i] = sigmoidf_(s[i]);
                u32x4 o; o.x = pk2(s[0], s[1]); o.y = pk2(s[2], s[3]); o.z = pk2(s[4], s[5]); o.w = pk2(s[6], s[7]);
                *(LAS u32x4*)(XL + tl * SQ_XLS + 128 + 32 * sub + 8 * q) = o;
            }
        }
    }
    asm volatile("s_waitcnt lgkmcnt(0)" ::: "memory");
    __builtin_amdgcn_sched_barrier(0);
    bf16x8 gw[4][4];
    if (do_g) {
#pragma unroll
        for (int ct = 0; ct < 4; ++ct)
#pragma unroll
            for (int ks = 0; ks < 4; ++ks) gw[ct][ks] = *(const bf16x8*)(G2H + (16 * ct + n) * 128 + 32 * ks + 8 * g);
    }
    float kx[4][4], vx[4][4], rx[4][4];
    float kk2 = 0.f;
#pragma unroll
    for (int ct = 0; ct < 4; ++ct) { const int co = 64 * h + 16 * ct + 4 * g;
        shift4_raw(rk_[ct], MUK + 16 * ct + 4 * g, MU, kx[ct]); shift4_raw(rv_[ct], MUV + 16 * ct + 4 * g, MU, vx[ct]); shift4_raw(rr_[ct], MUR + 16 * ct + 4 * g, MU, rx[ct]);
        const f32x4 kkp = *(const LAS f32x4*)(PAR + 16 * ct + 4 * g);
#pragma unroll
        for (int i = 0; i < 4; ++i) { const float q = kx[ct][i] * kkp[i]; kk2 += q * q; } }
    kk2 = xrow16_sum(kk2);
    __builtin_amdgcn_sched_barrier(0);
    const float inv = __builtin_amdgcn_rcpf(fmaxf(__builtin_amdgcn_sqrtf(kk2), 1e-12f));
    float bbr = 0.f, krs = 0.f, rks = 0.f, pp_ = 0.f, qq_ = 0.f, uu_ = 0.f, zz_ = 0.f;
    const LAS bf16* xb = XL + n * SQ_XLS + 8 * g;
    const int role = sl & 1;
    LAS unsigned char* sb = slot + (sl >> 1) * SQ_BLKB;
    bf16* GB = (bf16*)(ws + WS_GB) + (size_t)(rowbase + t) * 1024;
    bf16* BN1 = (bf16*)(ws + WS_BON1) + (size_t)(rowbase + t) * 512;
#pragma unroll
    for (int ct = 0; ct < 4; ++ct) {
        const int cl = 16 * ct + 4 * g, ch0 = 64 * h + cl;
        f32x4 ag = (f32x4){0.f, 0.f, 0.f, 0.f}, adc = ag, aic = ag;
        if (do_g) {
#pragma unroll
            for (int ks = 0; ks < 4; ++ks) ag = __builtin_amdgcn_mfma_f32_16x16x32_bf16(gw[ct][ks], *(const LAS bf16x8*)(xb + 128 + 32 * ks), ag, 0, 0, 0);
        }
#pragma unroll
        for (int ks = 0; ks < 2; ++ks) {
            adc = __builtin_amdgcn_mfma_f32_16x16x32_bf16(*(const LAS bf16x8*)(WLD + (16 * ct + n) * WLS2 + 32 * ks + 8 * g), *(const LAS bf16x8*)(xb + 32 * ks), adc, 0, 0, 0);
            aic = __builtin_amdgcn_mfma_f32_16x16x32_bf16(*(const LAS bf16x8*)(WLI + (16 * ct + n) * WLS2 + 32 * ks + 8 * g), *(const LAS bf16x8*)(xb + 64 + 32 * ks), aic, 0, 0, 0); }
        const f32x4 kkp = *(const LAS f32x4*)(PAR + cl), kap = *(const LAS f32x4*)(PAR + 64 + cl), rkp = *(const LAS f32x4*)(PAR + 128 + cl);
        const f32x4 w0p = *(const LAS f32x4*)(PAR + 192 + cl), a0p = *(const LAS f32x4*)(PAR + 256 + cl);
        f32x4 aav, wv, kdv, bbv, wrv;
#pragma unroll
        for (int i = 0; i < 4; ++i) {
            aav[i] = -(kx[ct][i] * kkp[i] * inv);
            const float dec = __expf(-0.60653065971f * sigmoidf_(w0p[i] + adc[i]));
            const float av = sigmoidf_(a0p[i] + aic[i]);
            const float kd = kx[ct][i] * (1.0f + (av - 1.0f) * kap[i]);
            const float bb = -aav[i] * av;
            const float r = rx[ct][i];
            wv[i] = dec; kdv[i] = kd; bbv[i] = bb; wrv[i] = dec * r;
            bbr += bb * r; krs += kd * r; rks += r * kd * rkp[i];
        }
        {
            f32x4 wn, an, rn;
#pragma unroll
            for (int i = 0; i < 4; ++i) { wn[i] = __shfl_xor(wv[i], 1);
                an[i] = __shfl_xor(aav[i], 1);
                rn[i] = __shfl_xor(wrv[i], 1); }
#pragma unroll
            for (int i = 0; i < 4; ++i) { pp_ += bbv[i] * an[i]; qq_ += kdv[i] * an[i]; uu_ += bbv[i] * rn[i]; zz_ += kdv[i] * rn[i]; }
            *(LAS f32x4*)(sb + 256 + role * 256 + cl * 4) = (f32x4){vx[ct][0], vx[ct][1], vx[ct][2], vx[ct][3]};
#pragma unroll
            for (int i = 0; i < 4; ++i) *(LAS unsigned*)(sb + 768 + (cl + i) * 8 + role * 4) = role ? pk2(bbv[i], kdv[i]) : pk2(bbv[i] * wn[i], kdv[i] * wn[i]);
            if (role == 0) {
                *(LAS f32x4*)(sb + cl * 4) = wv * wn;
                const int po = ((ct >> 1) * 4 + g) * 16 + (ct & 1) * 8;
                u32x2 o0, o1, o2, o3; o0.x = pk2(aav[0], aav[1]); o0.y = pk2(aav[2], aav[3]); o1.x = pk2(wrv[0], wrv[1]); o1.y = pk2(wrv[2], wrv[3]);
                o2.x = pk2(wv[0] * an[0], wv[1] * an[1]); o2.y = pk2(wv[2] * an[2], wv[3] * an[3]); o3.x = pk2(wv[0] * rn[0], wv[1] * rn[1]); o3.y = pk2(wv[2] * rn[2], wv[3] * rn[3]);
                *(LAS u32x2*)(sb + 1280 + po) = o0; *(LAS u32x2*)(sb + 1408 + po) = o1; *(LAS u32x2*)(sb + 1536 + po) = o2; *(LAS u32x2*)(sb + 1664 + po) = o3;
            }
        }
        if (do_g) { u32x2 o; o.x = pk2(ag[0], ag[1]); o.y = pk2(ag[2], ag[3]); *(u32x2*)(GB + ch0) = o; }
        __builtin_amdgcn_sched_barrier(0);
    }
    bbr = xrow16_sum(bbr); krs = xrow16_sum(krs); rks = xrow16_sum(rks); pp_ = xrow16_sum(pp_); qq_ = xrow16_sum(qq_); uu_ = xrow16_sum(uu_); zz_ = xrow16_sum(zz_);
    if (g == 0) { LAS float* scp = (LAS float*)(sb + 1792);
        if (role == 0) { *(LAS f32x4*)scp = (f32x4){bbr, krs, pp_, qq_}; *(LAS f32x2*)(scp + 4) = (f32x2){uu_, zz_}; } else *(LAS f32x2*)(scp + 6) = (f32x2){bbr, krs}; }
    if (!is_ctx) {
#pragma unroll
        for (int ct = 0; ct < 4; ++ct) { const int ch0 = 64 * h + 16 * ct + 4 * g;
            u32x2 o; o.x = pk2(rks * vx[ct][0], rks * vx[ct][1]); o.y = pk2(rks * vx[ct][2], rks * vx[ct][3]);
            if (dir == 0) *(u32x2*)(GB + 512 + ch0) = o; else *(u32x2*)(BN1 + ch0) = o; } }
}

typedef short s16x4 __attribute__((ext_vector_type(4)));
__device__ __forceinline__ unsigned lds_ld_acq(LAS unsigned* p) { return __hip_atomic_load(p, __ATOMIC_ACQUIRE, __HIP_MEMORY_SCOPE_WORKGROUP); }

__device__ __forceinline__ void p4_scan(ArgP a, const Ctx& F) {
    unsigned char* ws = a->ws;
    LAS unsigned* flags = (LAS unsigned*)(F.lds + SQ_FLAG);
    for (int chr = F.vcu; chr < 256 * PROBE_R_SCAN; chr += F.G) {
        const int ch = chr & 255, dir = ch >> 7, b = (ch >> 3) & 15, h = ch & 7;
        if (F.tid < 16) flags[F.tid] = 0u;
        if (F.tid < 128) ((LAS unsigned*)(F.lds + SQ_ZRB))[F.tid] = 0u;
        for (int i = F.tid; i < 2 * MUN; i += NTHR) { const int pn = i >= MUN, j = pn ? i - MUN : i;
            const int src = j < 64 ? (PC_KA - 1024) + 64 * h + j : (j < 128 ? (PC_VA - 1024) + 64 * h + (j - 64) : (j < 192 ? (PC_RA - 1024) + 64 * h + (j - 128) :
                            (j < 256 ? (PC_WD - 1024) + 64 * dir + (j - 192) : (j < 320 ? (PC_AD - 1024) + 64 * dir + (j - 256) : (PC_GD - 1024) + (j - 320)))));
            ((LAS float*)(F.lds + SQ_MU))[i] = pn ? a->in[I_MUN][src] : a->in[I_MUP][src]; }
        if (F.tid < 320) { const int q = F.tid >> 6, cc = 64 * h + (F.tid & 63);
            ((LAS float*)(F.lds + SQ_PAR))[F.tid] = q == 0 ? a->in[I_KK][cc] : (q == 1 ? a->in[I_KA][cc] : (q == 2 ? a->in[I_RK][cc] : (q == 3 ? a->in[I_W0][dir * 512 + cc] : a->in[I_A0][dir * 512 + cc]))); }
        {   const bf16* G2T = (const bf16*)(ws + WS_SMALLW); const bf16* W2T = G2T + 65536 + dir * 32768 + 64 * h * 64; const bf16* A2T = G2T + 131072 + dir * 32768 + 64 * h * 64;
            { const int row = F.tid >> 3, c8 = (F.tid & 7) * 8;
              *(LAS u32x4*)((LAS bf16*)(F.lds + SQ_WLD) + row * WLS2 + c8) = *(const u32x4*)(W2T + row * 64 + c8);
              *(LAS u32x4*)((LAS bf16*)(F.lds + SQ_WLI) + row * WLS2 + c8) = *(const u32x4*)(A2T + row * 64 + c8); }
}
        __syncthreads();
        if (F.wave >= 2 && F.wave < 2 + SQ_NPROD) {
            const int lw = F.wave - 2;
            __builtin_amdgcn_s_setprio(0);
            for (;;) {
                const int sc = __builtin_amdgcn_readfirstlane((int)__hip_atomic_fetch_add(flags + 10, 1u, __ATOMIC_RELAXED, __HIP_MEMORY_SCOPE_WORKGROUP)) >> 6;
                if (sc >= SQ_NSUB) break;
                if (sc >= SQ_NSLOT) {
                    const unsigned need = (unsigned)(sc - SQ_NSLOT + 1);
                    for (unsigned sp = 0; min(lds_ld_acq(flags + 6), lds_ld_acq(flags + 7)) < need && sp < (1u << 16); ++sp) __builtin_amdgcn_s_sleep(2);
                }
                scan_produce(a, F.lds, dir, b, h, sc, lw, F.lane);
                asm volatile("s_waitcnt lgkmcnt(0)" ::: "memory");
                if (F.lane == 0) __hip_atomic_store(flags + sc % SQ_NSLOT, (unsigned)(sc + 1), __ATOMIC_RELEASE, __HIP_MEMORY_SCOPE_WORKGROUP);
            }
        } else if (F.wave == 7) {
            __builtin_amdgcn_s_setprio(0);
            int bg_grp = (chr < F.G) ? F.vcu : BG_GROUPS, bg_k = 0;
            while (bg_grp < BG_GROUPS) {
                BgJob j0 = bg_job(a, bg_grp, bg_k, F.lane), j1 = bg_job(a, bg_grp, bg_k + 1, F.lane), j2 = bg_job(a, bg_grp, bg_k + 2, F.lane), j3 = bg_job(a, bg_grp, bg_k + 3, F.lane);
                f32x4 v0[BG_ROWS], v1[BG_ROWS], v2[BG_ROWS], v3[BG_ROWS];
                bg_issue(j0, v0); bg_issue(j1, v1); bg_issue(j2, v2); bg_issue(j3, v3);
                bg_finish(j0, v0); bg_finish(j1, v1); bg_finish(j2, v2); bg_finish(j3, v3);
                bg_k += 4; if (bg_k == BG_SUB) { bg_k = 0; bg_grp += F.G; }
            }
        } else {
            __builtin_amdgcn_s_setprio(3);
            unsigned* Y = (unsigned*)(ws + WS_Y) + (((size_t)dir * NTOK + (size_t)b * T) >> 1) * 512 + h * 64;
            const int riA = 32 * F.wave + (F.lane & 15), riB = riA + 16, g = F.lane >> 4;
            const int aoffb = (F.lane & 3) * 128 + g * 16;
            const LAS unsigned char* ZRB = (const LAS unsigned char*)(F.lds + SQ_ZRB);
            const LAS unsigned char* ZR = (const LAS unsigned char*)(flags + 12);
            f32x4 stA[4], stB[4];
#pragma unroll
            for (int i = 0; i < 4; ++i) { stA[i] = (f32x4){0.f, 0.f, 0.f, 0.f}; stB[i] = stA[i]; }
#pragma unroll 1
            for (int sc = 0; sc < SQ_NSUB; ++sc) {
                const int sq = sc % SQ_NSLOT;
                for (unsigned sp = 0; lds_ld_acq(flags + sq) != (unsigned)(sc + 1) && sp < (1u << 16); ++sp) __builtin_amdgcn_s_sleep(1);
                const LAS unsigned char* DB = (const LAS unsigned char*)(F.lds + SQ_RING + sq * SQ_SLOTB);
                const int s0 = sc * SQ_STEPS; const bool is_ctx = s0 < CTXL;
                const int t0 = dir == 0 ? s0 - CTXL : T - 1 - (s0 - CTXL); const int tstep = dir == 0 ? 1 : -1;
#define SCAN_LD(bk_, X) const LAS unsigned char* sp##X = DB + (bk_) * SQ_BLKB; \
                    const f32x4 w0##X = *(const LAS f32x4*)(sp##X + (0 + 4 * g) * 4), w1##X = *(const LAS f32x4*)(sp##X + (16 + 4 * g) * 4), w2##X = *(const LAS f32x4*)(sp##X + (32 + 4 * g) * 4), w3##X = *(const LAS f32x4*)(sp##X + (48 + 4 * g) * 4); \
                    const float vaA##X = *(const LAS float*)(sp##X + 256 + riA * 4), vbA##X = *(const LAS float*)(sp##X + 512 + riA * 4), vaB##X = *(const LAS float*)(sp##X + 256 + riB * 4), vbB##X = *(const LAS float*)(sp##X + 512 + riB * 4); \
                    const f32x4 sA##X = *(const LAS f32x4*)(sp##X + 1792), sB##X = *(const LAS f32x4*)(sp##X + 1808); \
                    const bf16x8 a0##X = *(const LAS bf16x8*)(sp##X + 1280 + aoffb), a1##X = *(const LAS bf16x8*)(sp##X + 1344 + aoffb); \
                    const LAS unsigned char* qb##X = g > 1 ? ZRB : sp##X + 768 + (F.lane & 15) * 8; \
                    const u32x2 q0##X = *(const LAS u32x2*)(qb##X), q1##X = *(const LAS u32x2*)(qb##X + 128), q2##X = *(const LAS u32x2*)(qb##X + 256), q3##X = *(const LAS u32x2*)(qb##X + 384)
#define SCAN_ROW(bk_, X, st, va_, vb_, ri_) do { \
                    u32x4 b0, b1; b0.x = pg8::cvt_pk_bf16(st[0][0], st[0][1]); b0.y = pg8::cvt_pk_bf16(st[0][2], st[0][3]); b0.z = pg8::cvt_pk_bf16(st[1][0], st[1][1]); b0.w = pg8::cvt_pk_bf16(st[1][2], st[1][3]); \
                    b1.x = pg8::cvt_pk_bf16(st[2][0], st[2][1]); b1.y = pg8::cvt_pk_bf16(st[2][2], st[2][3]); b1.z = pg8::cvt_pk_bf16(st[3][0], st[3][1]); b1.w = pg8::cvt_pk_bf16(st[3][2], st[3][3]); \
                    f32x4 dd = (f32x4){0.f, 0.f, 0.f, 0.f}; \
                    dd = __builtin_amdgcn_mfma_f32_16x16x32_bf16(a0##X, __builtin_bit_cast(bf16x8, b0), dd, 0, 0, 0); \
                    dd = __builtin_amdgcn_mfma_f32_16x16x32_bf16(a1##X, __builtin_bit_cast(bf16x8, b1), dd, 0, 0, 0); \
                    st[0] *= w0##X; st[1] *= w1##X; st[2] *= w2##X; st[3] *= w3##X; \
                    const float sa0 = dd[0]; \
                    const float sa1 = dd[2] + sa0 * sA##X[2] + va_ * sA##X[3]; \
                    float y0 = dd[1] + sa0 * sA##X[0] + va_ * sA##X[1]; \
                    float y1 = dd[3] + sa0 * sB##X[0] + va_ * sB##X[1] + sa1 * sB##X[2] + vb_ * sB##X[3]; \
                    const unsigned hA = pg8::cvt_pk_bf16(sa0, va_), hB = pg8::cvt_pk_bf16(sa1, vb_); \
                    const unsigned lA = pg8::cvt_pk_bf16(sa0 - __uint_as_float(hA << 16), va_ - __uint_as_float(hA & 0xffff0000u)), lB = pg8::cvt_pk_bf16(sa1 - __uint_as_float(hB << 16), vb_ - __uint_as_float(hB & 0xffff0000u)); \
                    u32x2 rb_; rb_.x = g == 0 ? hA : lA; rb_.y = g == 0 ? hB : lB;        \
                    const s16x4 rbv = __builtin_bit_cast(s16x4, rb_); \
                    st[0] = __builtin_amdgcn_mfma_f32_16x16x16bf16_1k(__builtin_bit_cast(s16x4, q0##X), rbv, st[0], 0, 0, 0); \
                    st[1] = __builtin_amdgcn_mfma_f32_16x16x16bf16_1k(__builtin_bit_cast(s16x4, q1##X), rbv, st[1], 0, 0, 0); \
                    st[2] = __builtin_amdgcn_mfma_f32_16x16x16bf16_1k(__builtin_bit_cast(s16x4, q2##X), rbv, st[2], 0, 0, 0); \
                    st[3] = __builtin_amdgcn_mfma_f32_16x16x16bf16_1k(__builtin_bit_cast(s16x4, q3##X), rbv, st[3], 0, 0, 0); \
                    asm volatile("" : "+v"(y0), "+v"(y1)); \
                    if (!is_ctx && F.lane < 16) Y[(size_t)(dir == 0 ? (t0 >> 1) + (bk_) : ((t0 - 1) >> 1) - (bk_)) * 512 + ri_] = pg8::cvt_pk_bf16(y0, y1); } while (0)
#define SCAN_DO(bk_, X) do { SCAN_ROW(bk_, X, stA, vaA##X, vbA##X, riA); SCAN_ROW(bk_, X, stB, vaB##X, vbB##X, riB); } while (0)
#pragma unroll 1
                for (int bk = 0; bk < 8; bk += 4) {
                    SCAN_LD(bk, A); SCAN_LD(bk + 1, B);
                    SCAN_DO(bk, A);
                    SCAN_LD(bk + 2, C);
                    SCAN_DO(bk + 1, B);
                    SCAN_LD(bk + 3, D);
                    SCAN_DO(bk + 2, C);
                    SCAN_DO(bk + 3, D);
                }
#undef SCAN_LD
#undef SCAN_ROW
#undef SCAN_DO
                asm volatile("s_waitcnt lgkmcnt(0)" ::: "memory");
                if (F.lane == 0) __hip_atomic_store(flags + 6 + F.wave, (unsigned)(sc + 1), __ATOMIC_RELEASE, __HIP_MEMORY_SCOPE_WORKGROUP);
            }
            __builtin_amdgcn_s_setprio(0);
        }
        __syncthreads();
    }
}


__device__ __forceinline__ float xrow16_max(float x) {
    auto s = __builtin_amdgcn_permlane16_swap(__float_as_uint(x), __float_as_uint(x), false, false);
    x = fmaxf(__uint_as_float(s[0]), __uint_as_float(s[1]));
    auto t = __builtin_amdgcn_permlane32_swap(__float_as_uint(x), __float_as_uint(x), false, false);
    return fmaxf(__uint_as_float(t[0]), __uint_as_float(t[1]));
}
constexpr int NA_RP = 0, NA_KC = 16384, NA_KCS = 72, NA_VC = NA_KC + 256 * NA_KCS * 2, NA_VCS = 264, NA_END = NA_VC + 64 * NA_VCS * 2;
static_assert(NA_END <= LDSCTL_OFF, "natten LDS map");
__device__ __forceinline__ void p5_natten(ArgP a, const Ctx& F) {
    const bf16* P = (const bf16*)(a->ws + WS_P); const bf16* VT = (const bf16*)(a->ws + WS_VT); const bf16* KB = (const bf16*)(a->ws + WS_KB); bf16* O = (bf16*)(a->ws + WS_H);
    LAS float* RP = (LAS float*)(F.lds + NA_RP);
    LAS bf16* KC = (LAS bf16*)(F.lds + NA_KC); LAS bf16* VC = (LAS bf16*)(F.lds + NA_VC);
    {   float rv[8];
#pragma unroll
        for (int q = 0; q < 8; ++q) { const int i = F.tid + NTHR * q; rv[q] = i < 8 * 15 * 31 ? a->in[I_RPB][i] : 0.f; }
#pragma unroll
        for (int q = 0; q < 8; ++q) { const int i = F.tid + NTHR * q; if (i < 8 * 15 * 31) RP[i] = rv[q]; } }
    const int g = F.lane >> 4, n = F.lane & 15;
    for (int wir = F.vcu; wir < 256 * PROBE_R_NA; wir += F.G) {
        const int wi = wir & 255, bh = wi >> 1, half = wi & 1, b = bh >> 3, h = bh & 7;
        __syncthreads();
        const bf16* KBh = KB + (size_t)(b * 8 + h) * TT * 64; const bf16* VTh = VT + (size_t)(b * 8 + h) * TT * 64;
#pragma unroll
        for (int k = 0; k < 4; ++k) { const int idx = F.tid + NTHR * k;
            { const int r8 = idx & 7, dg = (idx >> 3) & 7, blk = idx >> 6; *(LAS u32x4*)(KC + (blk * 8 + r8) * NA_KCS + dg * 8) = *(const u32x4*)(KBh + (size_t)idx * 8); }
            { const int dim = idx & 63, blk = idx >> 6; *(LAS u32x4*)(VC + dim * NA_VCS + blk * 8) = *(const u32x4*)(VTh + (size_t)idx * 8); } }
        __syncthreads();
        bf16x8 q0n, q1n, kfn[16];
        {   const int r = half * 16 + F.wave * 2, r_start = min(max(r - 4, 0), 24);
            const bf16* qp = P + (size_t)(b * T + r * 64 + n) * PW + 64 * h + 8 * g; q0n = *(const bf16x8*)qp; q1n = *(const bf16x8*)(qp + 32);
            const bf16* kb = KBh + (size_t)(((((CTXL + r_start * 64) >> 3) + (n >> 3)) * 64 + g * 8 + (n & 7)) * 8);
#pragma unroll
            for (int t = 0; t < 8; ++t) { const int ro = ((t >> 1) * 8 + (t & 1) * 2) * 512; kfn[2 * t] = *(const bf16x8*)(kb + ro); kfn[2 * t + 1] = *(const bf16x8*)(kb + ro + 256); } }
#pragma unroll 1
        for (int t8 = 0; t8 < 8; ++t8) {
            const int r = half * 16 + F.wave * 2 + (t8 >> 2), qt = t8 & 3;
            const int r_start = min(max(r - 4, 0), 24), wlo = qt == 0 ? 0 : (qt == 1 ? 8 : (qt == 2 ? 24 : 32));
            const int c = 16 * qt + n, c_start = min(max(c - 8, 0), 48);
            const bf16x8 q0 = q0n, q1 = q1n;
            const bf16* kb = KBh + (size_t)(((((CTXL + r_start * 64 + wlo) >> 3) + (n >> 3)) * 64 + g * 8 + (n & 7)) * 8);
            bf16x8 kf[16];
#pragma unroll
            for (int t = 0; t < 16; ++t) kf[t] = kfn[t];
            __builtin_amdgcn_sched_barrier(0);
            float mx, sum; f32x4 o[4];
            {   float s[16][4];
#pragma unroll
                for (int t = 0; t < 16; ++t) { const LAS bf16* kp = KC + (16 * t + n) * NA_KCS + 8 * g;
                    f32x4 acc = (f32x4){0.f, 0.f, 0.f, 0.f};
                    acc = __builtin_amdgcn_mfma_f32_16x16x32_bf16(*(const LAS bf16x8*)kp, q0, acc, 0, 0, 0);
                    acc = __builtin_amdgcn_mfma_f32_16x16x32_bf16(*(const LAS bf16x8*)(kp + 32), q1, acc, 0, 0, 0);
#pragma unroll
                    for (int i = 0; i < 4; ++i) s[t][i] = acc[i]; }
                mx = -INFINITY;
#pragma unroll
                for (int t = 0; t < 16; ++t)
#pragma unroll
                    for (int i = 0; i < 4; ++i) mx = fmaxf(mx, s[t][i]);
                mx = xrow16_max(mx);
                sum = 0.f;
#pragma unroll
                for (int dt = 0; dt < 4; ++dt) o[dt] = (f32x4){0.f, 0.f, 0.f, 0.f};
#pragma unroll
                for (int pp = 0; pp < 8; ++pp) {
                    float e[8];
#pragma unroll
                    for (int i = 0; i < 4; ++i) { e[i] = __expf(s[2 * pp][i] - mx); e[4 + i] = __expf(s[2 * pp + 1][i] - mx); }
#pragma unroll
                    for (int i = 0; i < 8; ++i) sum += e[i];
                    u32x4 w; w.x = pk2(e[0], e[1]); w.y = pk2(e[2], e[3]); w.z = pk2(e[4], e[5]); w.w = pk2(e[6], e[7]);
                    const bf16x8 pf = __builtin_bit_cast(bf16x8, w);
#pragma unroll
                    for (int dt = 0; dt < 4; ++dt) { const LAS bf16* vp = VC + (16 * dt + n) * NA_VCS + 32 * pp + 4 * g;
                        const u32x2 lo = *(const LAS u32x2*)vp, hi = *(const LAS u32x2*)(vp + 16);
                        const u32x4 vv = (u32x4){lo.x, lo.y, hi.x, hi.y};
                        o[dt] = __builtin_amdgcn_mfma_f32_16x16x32_bf16(__builtin_bit_cast(bf16x8, vv), pf, o[dt], 0, 0, 0); }
                }
                sum = xrow16_sum(sum);
            }
            __builtin_amdgcn_sched_barrier(0);
            float s[16][4];
#pragma unroll
            for (int t = 0; t < 8; ++t) {
                f32x4 acc = (f32x4){0.f, 0.f, 0.f, 0.f};
                acc = __builtin_amdgcn_mfma_f32_16x16x32_bf16(kf[2 * t], q0, acc, 0, 0, 0);
                acc = __builtin_amdgcn_mfma_f32_16x16x32_bf16(kf[2 * t + 1], q1, acc, 0, 0, 0);
#pragma unroll
                for (int i = 0; i < 4; ++i) s[t][i] = acc[i]; }
            __builtin_amdgcn_sched_barrier(0);
#pragma unroll
            for (int t8b = 0; t8b < 8; ++t8b) { const int t = 8 + t8b; const int ro = ((t >> 1) * 8 + (t & 1) * 2) * 512; kf[2 * t8b] = *(const bf16x8*)(kb + ro); kf[2 * t8b + 1] = *(const bf16x8*)(kb + ro + 256); }
            const bf16* vb = VT + (size_t)(b * 8 + h) * TT * 64 + (size_t)(((((CTXL + r_start * 64 + wlo) >> 3) + (g >> 1)) * 64 + n) * 8 + 4 * (g & 1));
            constexpr int SDT = 8, SPP = 8 * 64 * 8, SHI = 2 * 64 * 8;
            u32x2 vlo[16], vhi[16];
#pragma unroll
            for (int pp = 0; pp < 4; ++pp)
#pragma unroll
                for (int dt = 0; dt < 4; ++dt) { const bf16* vp = vb + (size_t)(16 * dt) * SDT + pp * SPP; vlo[pp * 4 + dt] = *(const u32x2*)vp; vhi[pp * 4 + dt] = *(const u32x2*)(vp + SHI); }
            __builtin_amdgcn_sched_barrier(0);
#pragma unroll
            for (int t8b = 0; t8b < 8; ++t8b) { const int t = 8 + t8b;
                f32x4 acc = (f32x4){0.f, 0.f, 0.f, 0.f};
                acc = __builtin_amdgcn_mfma_f32_16x16x32_bf16(kf[2 * t8b], q0, acc, 0, 0, 0);
                acc = __builtin_amdgcn_mfma_f32_16x16x32_bf16(kf[2 * t8b + 1], q1, acc, 0, 0, 0);
#pragma unroll
                for (int i = 0; i < 4; ++i) s[t][i] = acc[i]; }
            __builtin_amdgcn_sched_barrier(0);
#pragma unroll
            for (int t = 0; t < 16; ++t) { const LAS float* rp = RP + h * 465 + (r_start + (t >> 1) - r + 7) * 31;
#pragma unroll
                for (int i = 0; i < 4; ++i) { const int kc = wlo + 16 * (t & 1) + 4 * g + i; const bool ok = (kc >= c_start) && (kc < c_start + 16);
                    const int dc = min(max(kc - c + 15, 0), 30);
                    s[t][i] = ok ? s[t][i] + rp[dc] : -INFINITY; } }
            float ml = -INFINITY;
#pragma unroll
            for (int t = 0; t < 16; ++t)
#pragma unroll
                for (int i = 0; i < 4; ++i) ml = fmaxf(ml, s[t][i]);
            ml = xrow16_max(ml);
            const float m = fmaxf(mx, ml), fc = __expf(mx - m);
            float suml = 0.f;
#pragma unroll
            for (int dt = 0; dt < 4; ++dt) o[dt] *= fc;
            bf16x8 pf[8];
#pragma unroll
            for (int pp = 0; pp < 8; ++pp) {
                float e[8];
#pragma unroll
                for (int i = 0; i < 4; ++i) { e[i] = __expf(s[2 * pp][i] - m); e[4 + i] = __expf(s[2 * pp + 1][i] - m); }
#pragma unroll
                for (int i = 0; i < 8; ++i) suml += e[i];
                u32x4 w; w.x = pk2(e[0], e[1]); w.y = pk2(e[2], e[3]); w.z = pk2(e[4], e[5]); w.w = pk2(e[6], e[7]);
                pf[pp] = __builtin_bit_cast(bf16x8, w);
            }
            suml = xrow16_sum(suml);
#pragma unroll
            for (int pp = 0; pp < 4; ++pp)
#pragma unroll
                for (int dt = 0; dt < 4; ++dt) { const u32x4 w = (u32x4){vlo[pp * 4 + dt].x, vlo[pp * 4 + dt].y, vhi[pp * 4 + dt].x, vhi[pp * 4 + dt].y};
                    o[dt] = __builtin_amdgcn_mfma_f32_16x16x32_bf16(__builtin_bit_cast(bf16x8, w), pf[pp], o[dt], 0, 0, 0); }
#pragma unroll
            for (int pp = 4; pp < 8; ++pp)
#pragma unroll
                for (int dt = 0; dt < 4; ++dt) { const bf16* vp = vb + (size_t)(16 * dt) * SDT + pp * SPP; vlo[(pp - 4) * 4 + dt] = *(const u32x2*)vp; vhi[(pp - 4) * 4 + dt] = *(const u32x2*)(vp + SHI); }
            {   const int t9 = t8 < 7 ? t8 + 1 : 7, r9 = half * 16 + F.wave * 2 + (t9 >> 2), q9 = t9 & 3, rs9 = min(max(r9 - 4, 0), 24), wl9 = q9 == 0 ? 0 : (q9 == 1 ? 8 : (q9 == 2 ? 24 : 32));
                const bf16* qp = P + (size_t)(b * T + r9 * 64 + 16 * q9 + n) * PW + 64 * h + 8 * g; q0n = *(const bf16x8*)qp; q1n = *(const bf16x8*)(qp + 32);
                const bf16* kb9 = KBh + (size_t)(((((CTXL + rs9 * 64 + wl9) >> 3) + (n >> 3)) * 64 + g * 8 + (n & 7)) * 8);
#pragma unroll
                for (int t = 0; t < 8; ++t) { const int ro = ((t >> 1) * 8 + (t & 1) * 2) * 512; kfn[2 * t] = *(const bf16x8*)(kb9 + ro); kfn[2 * t + 1] = *(const bf16x8*)(kb9 + ro + 256); } }
#pragma unroll
            for (int pp = 4; pp < 8; ++pp)
#pragma unroll
                for (int dt = 0; dt < 4; ++dt) { const u32x4 w = (u32x4){vlo[(pp - 4) * 4 + dt].x, vlo[(pp - 4) * 4 + dt].y, vhi[(pp - 4) * 4 + dt].x, vhi[(pp - 4) * 4 + dt].y};
                    o[dt] = __builtin_amdgcn_mfma_f32_16x16x32_bf16(__builtin_bit_cast(bf16x8, w), pf[pp], o[dt], 0, 0, 0); }
            const float inv = __builtin_amdgcn_rcpf(sum * fc + suml);
            unsigned char* op = (unsigned char*)O + (size_t)(b * T + r * 64 + c) * D + 512 + 64 * h + 4 * g;
            const float inq = inv * Q_SA;
#pragma unroll
            for (int dt = 0; dt < 4; ++dt) *(unsigned*)(op + 16 * dt) = pk4_fp8(o[dt][0] * inq, o[dt][1] * inq, o[dt][2] * inq, o[dt][3] * inq);
        }
    }
    __syncthreads();
}

__device__ __forceinline__ void p6_post(ArgP a, const Ctx& F) {
    const unsigned* Y0 = (const unsigned*)(a->ws + WS_Y); const unsigned* Y1 = Y0 + (size_t)(NTOK / 2) * 512;
    const bf16* GB = (const bf16*)(a->ws + WS_GB); const bf16* BN1 = (const bf16*)(a->ws + WS_BON1); bf16* O = (bf16*)(a->ws + WS_H);
    const int gw = F.vcu * NWAVES + F.wave, NGW = F.G * NWAVES, ch0 = 8 * F.lane;
    const f32x4 lg0 = *(const f32x4*)(a->in[I_LNXG] + ch0), lg1 = *(const f32x4*)(a->in[I_LNXG] + ch0 + 4), lb0 = *(const f32x4*)(a->in[I_LNXB] + ch0), lb1 = *(const f32x4*)(a->in[I_LNXB] + ch0 + 4);
    for (int pr = gw; pr < (NTOK / 2) * PROBE_R_POST; pr += NGW) { const int pp = pr & (NTOK / 2 - 1);
        const u32x4 d0 = *(const u32x4*)(Y0 + (size_t)pp * 512 + ch0), d1 = *(const u32x4*)(Y0 + (size_t)pp * 512 + ch0 + 4), e0 = *(const u32x4*)(Y1 + (size_t)pp * 512 + ch0), e1 = *(const u32x4*)(Y1 + (size_t)pp * 512 + ch0 + 4);
        u32x4 ggq[2], bnq[2], b1q[2];
#pragma unroll
        for (int q = 0; q < 2; ++q) { const int tok = 2 * pp + q; ggq[q] = *(const u32x4*)(GB + (size_t)tok * 1024 + ch0); bnq[q] = *(const u32x4*)(GB + (size_t)tok * 1024 + 512 + ch0); b1q[q] = *(const u32x4*)(BN1 + (size_t)tok * 512 + ch0); }
#pragma unroll
      for (int q = 0; q < 2; ++q) { const int tok = 2 * pp + q;
        f32x4 ya, yb;
#pragma unroll
        for (int i = 0; i < 4; ++i) { ya[i] = q == 0 ? bflo(d0[i]) + bfhi(e0[i]) : bfhi(d0[i]) + bflo(e0[i]); yb[i] = q == 0 ? bflo(d1[i]) + bfhi(e1[i]) : bfhi(d1[i]) + bflo(e1[i]); }
        const u32x4 gg = ggq[q], bn = bnq[q], b1 = b1q[q];
        float sm = (ya.x + ya.y) + (ya.z + ya.w) + (yb.x + yb.y) + (yb.z + yb.w);
        sm += __shfl_xor(sm, 1); sm += __shfl_xor(sm, 2); sm += __shfl_xor(sm, 4);
        const float mu = sm * (1.0f / 64.0f);
        ya -= mu; yb -= mu;
        float sq = (ya.x * ya.x + ya.y * ya.y) + (ya.z * ya.z + ya.w * ya.w) + (yb.x * yb.x + yb.y * yb.y) + (yb.z * yb.z + yb.w * yb.w);
        sq += __shfl_xor(sq, 1); sq += __shfl_xor(sq, 2); sq += __shfl_xor(sq, 4);
        const float rs = __frsqrt_rn(sq * (1.0f / 64.0f) + 64e-5f);
        float r[8];
        r[0] = (ya.x * rs * lg0.x + lb0.x + bflo(bn.x) + bflo(b1.x)) * bflo(gg.x); r[1] = (ya.y * rs * lg0.y + lb0.y + bfhi(bn.x) + bfhi(b1.x)) * bfhi(gg.x);
        r[2] = (ya.z * rs * lg0.z + lb0.z + bflo(bn.y) + bflo(b1.y)) * bflo(gg.y); r[3] = (ya.w * rs * lg0.w + lb0.w + bfhi(bn.y) + bfhi(b1.y)) * bfhi(gg.y);
        r[4] = (yb.x * rs * lg1.x + lb1.x + bflo(bn.z) + bflo(b1.z)) * bflo(gg.z); r[5] = (yb.y * rs * lg1.y + lb1.y + bfhi(bn.z) + bfhi(b1.z)) * bfhi(gg.z);
        r[6] = (yb.z * rs * lg1.z + lb1.z + bflo(bn.w) + bflo(b1.w)) * bflo(gg.w); r[7] = (yb.w * rs * lg1.w + lb1.w + bfhi(bn.w) + bfhi(b1.w)) * bfhi(gg.w);
        u32x2 w; w.x = pk4_fp8(r[0] * Q_SA, r[1] * Q_SA, r[2] * Q_SA, r[3] * Q_SA); w.y = pk4_fp8(r[4] * Q_SA, r[5] * Q_SA, r[6] * Q_SA, r[7] * Q_SA);
        *(u32x2*)((unsigned char*)O + (size_t)tok * D + ch0) = w;
      }
    }
}

constexpr int RW_S = 1028;
__device__ __forceinline__ unsigned rt_key(float v, int e) { const unsigned u = __float_as_uint(v); const unsigned s = (u & 0x80000000u) ? ~u : (u | 0x80000000u); return (s & ~31u) | (unsigned)(31 - e); }
__device__ __forceinline__ float rt_val(unsigned k) { const unsigned s = k & ~31u; return __uint_as_float((s & 0x80000000u) ? (s & 0x7fffffffu) : ~s); }
__device__ __forceinline__ void p8_router(ArgP a, const Ctx& F, int l) {
    unsigned char* ws = a->ws;
    const bf16* X1 = (const bf16*)(ws + WS_X1); bf16* H = (bf16*)(ws + WS_H);
    const float* mod = (const float*)(ws + WS_MOD) + (size_t)l * 16 * 6144;
    const float* rwt = (const float*)(ws + WS_SMALLW + 393216) + (size_t)l * 32 * 1024;
    int* cnt = (int*)(ws + RT_CNT); int* toke = (int*)(ws + RT_TOKE); int* rank = (int*)(ws + RT_RANK); float* gate = (float*)(ws + RT_GATE);
    LAS float* RW = (LAS float*)F.lds; LAS float* GS = RW + 32 * RW_S; LAS float* C0 = GS + 1024; LAS int* hist = (LAS int*)(F.lds + LDSCTL_OFF + 1024);
    {   f32x4 rv[16];
#pragma unroll
        for (int q = 0; q < 16; ++q) rv[q] = ((const f32x4*)rwt)[F.tid + NTHR * q];
#pragma unroll
        for (int q = 0; q < 16; ++q) { const int i = F.tid + NTHR * q, e = i >> 8, c = i & 255; *(LAS f32x4*)(RW + e * RW_S + 4 * c) = rv[q]; } }
    if (F.tid < 32) hist[F.tid] = 0;
    const int g = F.lane >> 4, mn = F.lane & 15;
    for (int chunkr = F.vcu; chunkr < NCHUNK * PROBE_R_ROUTER; chunkr += F.G) {
        const int chunk = chunkr & (NCHUNK - 1), b = chunk >> 4;
        const float* mb = mod + (size_t)b * 6144;
        __syncthreads();
        for (int k = F.tid; k < 1024; k += NTHR) GS[k] = a->in[I_NFFNG][l * 1024 + k] * (1.0f + mb[4096 + k]);
        {   const int e = F.tid >> 4, part = F.tid & 15; float s = 0.f;
            f32x4 shv[16];
#pragma unroll
            for (int i = 0; i < 16; ++i) shv[i] = *(const f32x4*)(mb + 3072 + part * 64 + 4 * i);
#pragma unroll
            for (int i = 0; i < 16; ++i) { const f32x4 w = *(const LAS f32x4*)(RW + e * RW_S + part * 64 + 4 * i), sh = shv[i]; s += (w.x * sh.x + w.y * sh.y) + (w.z * sh.z + w.w * sh.w); }
            s += __shfl_xor(s, 1); s += __shfl_xor(s, 2); s += __shfl_xor(s, 4); s += __shfl_xor(s, 8);
            if (part == 0) C0[e] = s + a->in[I_RB][l * 32 + e]; }
        __syncthreads();
        const int row0 = chunk * CHUNK_ROWS + F.wave * 16;
        f32x4 acc0 = (f32x4){0.f, 0.f, 0.f, 0.f}, acc1 = acc0; float ss = 0.f;
        const bf16* xp = X1 + (size_t)(row0 + mn) * D + 4 * g;
#pragma unroll 1
        for (int j0 = 0; j0 < 64; j0 += 32) {
            u32x2 xq[32];
#pragma unroll
            for (int j = 0; j < 32; ++j) xq[j] = *(const u32x2*)(xp + 16 * (j0 + j));
#pragma unroll
            for (int j = 0; j < 32; ++j) { const int jj = j0 + j; const u32x2 xb = xq[j];
                const f32x4 gs = *(const LAS f32x4*)(GS + 16 * jj + 4 * g), w0 = *(const LAS f32x4*)(RW + mn * RW_S + 16 * jj + 4 * g), w1 = *(const LAS f32x4*)(RW + (16 + mn) * RW_S + 16 * jj + 4 * g);
                const f32x4 x = (f32x4){bflo(xb.x), bfhi(xb.x), bflo(xb.y), bfhi(xb.y)};
                ss += (x.x * x.x + x.y * x.y) + (x.z * x.z + x.w * x.w);
                const f32x4 xs = x * gs;
#pragma unroll
                for (int i = 0; i < 4; ++i) { acc0 = __builtin_amdgcn_mfma_f32_16x16x4f32(xs[i], w0[i], acc0, 0, 0, 0); acc1 = __builtin_amdgcn_mfma_f32_16x16x4f32(xs[i], w1[i], acc1, 0, 0, 0); }
                if ((j & 3) == 3) __builtin_amdgcn_sched_barrier(0);
            }
        }
        ss = xrow16_sum(ss);
        const float rstd_m = __frsqrt_rn(ss * (1.0f / D) + 1e-6f);
        const float c0a = C0[mn], c0b = C0[16 + mn];
        unsigned win[4][4];
#pragma unroll
        for (int i = 0; i < 4; ++i) {
            const float rs = __shfl(rstd_m, 4 * g + i);
            unsigned k0 = rt_key(rs * acc0[i] + c0a, mn), k1 = rt_key(rs * acc1[i] + c0b, 16 + mn);
#pragma unroll
            for (int r = 0; r < 4; ++r) {
                unsigned c = max(k0, k1);
                c = max(c, (unsigned)__shfl_xor((int)c, 1)); c = max(c, (unsigned)__shfl_xor((int)c, 2)); c = max(c, (unsigned)__shfl_xor((int)c, 4)); c = max(c, (unsigned)__shfl_xor((int)c, 8));
                win[i][r] = c; k0 = (k0 == c) ? 0u : k0; k1 = (k1 == c) ? 0u : k1;
            }
        }
        {
            const int ti = mn >> 2, kk = mn & 3;
            unsigned w4[4];
#pragma unroll
            for (int r = 0; r < 4; ++r) w4[r] = ti == 0 ? win[0][r] : (ti == 1 ? win[1][r] : (ti == 2 ? win[2][r] : win[3][r]));
            const float v0 = rt_val(w4[0]);
            const float e1 = __expf(rt_val(w4[1]) - v0), e2 = __expf(rt_val(w4[2]) - v0), e3 = __expf(rt_val(w4[3]) - v0);
            const float inv = __builtin_amdgcn_rcpf(1.0f + e1 + e2 + e3);
            const unsigned wk = kk == 0 ? w4[0] : (kk == 1 ? w4[1] : (kk == 2 ? w4[2] : w4[3]));
            const int e = 31 - (int)(wk & 31u);
            const float gv = (kk == 0 ? 1.0f : (kk == 1 ? e1 : (kk == 2 ? e2 : e3))) * inv;
            const int rk = __hip_atomic_fetch_add(&hist[e], 1, __ATOMIC_RELAXED, __HIP_MEMORY_SCOPE_WORKGROUP);
            const int pi = (row0 + 4 * g + ti) * 4 + kk;
            toke[pi] = e; rank[pi] = rk; gate[pi] = gv;
        }
#pragma unroll 1
        for (int r8 = 0; r8 < 16; r8 += 8) {
            u32x2 xr[8][4];
#pragma unroll
            for (int q = 0; q < 8; ++q)
#pragma unroll
                for (int j = 0; j < 4; ++j) xr[q][j] = ((const u32x2*)(X1 + (size_t)(row0 + r8 + q) * D))[F.lane + 64 * j];
#pragma unroll
            for (int q = 0; q < 8; ++q) { const int row = row0 + r8 + q; f32x4 v[4];
#pragma unroll
                for (int j = 0; j < 4; ++j) v[j] = (f32x4){bflo(xr[q][j].x), bfhi(xr[q][j].x), bflo(xr[q][j].y), bfhi(xr[q][j].y)};
                row_adaln(v, a->in[I_NFFNG] + l * 1024, mb + 3072, mb + 4096, F.lane);
                unsigned char* h8 = (unsigned char*)H + (size_t)row * D;
                row_store_fp8_wt(h8, F.lane, v, Q_SA);
            }
        }
        __syncthreads();
        if (F.tid < 32) { cnt[chunk * 32 + F.tid] = hist[F.tid]; hist[F.tid] = 0; }
    }
    __syncthreads();
}

__device__ __forceinline__ void p9_slots(ArgP a, const Ctx& F) {
    unsigned char* ws = a->ws;
    const int* cnt = (const int*)(ws + RT_CNT); const int* toke = (const int*)(ws + RT_TOKE); const int* rank = (const int*)(ws + RT_RANK);
    int* pslot = (int*)(ws + RT_PSLOT); int* stok = (int*)(ws + RT_STOK); int* tilee = (int*)(ws + RT_TILEE);
    LAS int* tot = (LAS int*)(F.lds); LAS int* off = tot + 32; LAS int* pst = tot + 64;
    for (int chunk = F.vcu; chunk < NCHUNK; chunk += F.G) {
        if (F.tid < 64) tot[F.tid] = 0;
        __syncthreads();
        { const int e = F.tid & 31, part = F.tid >> 5; int t = 0, o = 0;
          int v[NCHUNK / 16];
#pragma unroll
          for (int i = 0; i < NCHUNK / 16; ++i) v[i] = cnt[(part + 16 * i) * 32 + e];
#pragma unroll
          for (int i = 0; i < NCHUNK / 16; ++i) { t += v[i]; if (part + 16 * i < chunk) o += v[i]; }
          __hip_atomic_fetch_add(&tot[e], t, __ATOMIC_RELAXED, __HIP_MEMORY_SCOPE_WORKGROUP); __hip_atomic_fetch_add(&off[e], o, __ATOMIC_RELAXED, __HIP_MEMORY_SCOPE_WORKGROUP); }
        __syncthreads();
        if (F.tid == 0) { int p = 0; for (int e = 0; e < 32; ++e) { pst[e] = p; p += (tot[e] + 255) & ~255; } pst[32] = p; }
        __syncthreads();
        { const int pi = chunk * CHUNK_ROWS * 4 + F.tid; const int e = toke[pi]; const int slot = pst[e] + off[e] + rank[pi]; pslot[pi] = slot; stok[slot] = pi >> 2; }
        if (chunk < 32) {
            const int e = chunk; const int s0 = pst[e] + tot[e], s1 = pst[e + 1]; for (int s = s0 + F.tid; s < s1; s += NTHR) stok[s] = 0;
            for (int t = (pst[e] >> 8) + F.tid; t < (pst[e + 1] >> 8); t += NTHR) tilee[t] = e;
            if (chunk == 0 && F.tid == 0) tilee[1023] = pst[32] >> 8;
        }
        __syncthreads();
    }
}

__device__ __forceinline__ void p12_combine(ArgP a, const Ctx& F, int l) {
    unsigned char* ws = a->ws;
    bf16* X1 = (bf16*)(ws + WS_X1); const bf16* YB = (const bf16*)(ws + WS_YB); bf16* H = (bf16*)(ws + WS_H);
    const int* pslot = (const int*)(ws + RT_PSLOT); const float* gate = (const float*)(ws + RT_GATE);
    const float* mod = (const float*)(ws + WS_MOD);
    const int gw = F.vcu * NWAVES + F.wave, NGW = F.G * NWAVES;
    for (int chr = gw; chr < (NTOK / 16) * (l == 1 ? PROBE_R_COMB : 1); chr += NGW) {
        const int chunk = chr & (NTOK / 16 - 1), rowb = chunk * 16;
#ifdef PROBE_COMB_FAKE
        const bool fake = chr >= NTOK / 16;
        const int ps = fake ? rowb * 4 + (int)F.lane : pslot[rowb * 4 + F.lane]; const float gt = gate[rowb * 4 + F.lane];
        float* outp = fake ? (float*)(ws + WS_SS) : a->out;
#else
        const int ps = pslot[rowb * 4 + F.lane]; const float gt = gate[rowb * 4 + F.lane];
        float* outp = a->out;
#endif
        const float* g2 = mod + (size_t)(l * 16 + (rowb >> 11)) * 6144 + 5120;
        f32x4 g2v[4], pa[4], pb[4];
#pragma unroll
        for (int j = 0; j < 4; ++j) { g2v[j] = ((const f32x4*)g2)[F.lane + 64 * j];
            if (l == 0) { const float* m1 = mod + (size_t)(16 + (rowb >> 11)) * 6144; pa[j] = ((const f32x4*)(a->in[I_NMIXG] + 1024))[F.lane + 64 * j] * (((const f32x4*)(m1 + 1024))[F.lane + 64 * j] + 1.0f); pb[j] = ((const f32x4*)m1)[F.lane + 64 * j]; }
            else { pa[j] = ((const f32x4*)a->in[I_FING])[F.lane + 64 * j]; pb[j] = (f32x4){0.f, 0.f, 0.f, 0.f}; } }
#pragma unroll 1
        for (int i = 0; i < 16; i += 4) {
            u32x2 xr[4][4], yr[4][4][4]; float gv[4][4];
#pragma unroll
            for (int q = 0; q < 4; ++q) { const int row = rowb + i + q;
#pragma unroll
                for (int j = 0; j < 4; ++j) xr[q][j] = ((const u32x2*)(X1 + (size_t)row * D))[F.lane + 64 * j];
#pragma unroll
                for (int k = 0; k < 4; ++k) { const int slot = __builtin_amdgcn_readlane(ps, 4 * (i + q) + k); gv[q][k] = __builtin_bit_cast(float, __builtin_amdgcn_readlane(__builtin_bit_cast(int, gt), 4 * (i + q) + k));
                    const u32x2* yp = (const u32x2*)(YB + (size_t)slot * D);
#pragma unroll
                    for (int j = 0; j < 4; ++j) yr[q][k][j] = yp[F.lane + 64 * j]; } }
#pragma unroll
            for (int q = 0; q < 4; ++q) { const int row = rowb + i + q;
                f32x4 v[4];
#pragma unroll
                for (int j = 0; j < 4; ++j) { f32x4 mm = (f32x4){0.f, 0.f, 0.f, 0.f};
#pragma unroll
                    for (int k = 0; k < 4; ++k) { const u32x2 y = yr[q][k][j]; mm.x += gv[q][k] * bflo(y.x); mm.y += gv[q][k] * bfhi(y.x); mm.z += gv[q][k] * bflo(y.y); mm.w += gv[q][k] * bfhi(y.y); }
                    v[j] = (f32x4){bflo(xr[q][j].x), bfhi(xr[q][j].x), bflo(xr[q][j].y), bfhi(xr[q][j].y)} + g2v[j] * mm; }
                if (l == 0) {
                    row_store_bf16_wt(X1 + (size_t)row * D, F.lane, v);
                    { const float rs = row_rstd(v);
#pragma unroll
                      for (int j = 0; j < 4; ++j) v[j] = (v[j] * rs) * pa[j] + pb[j]; }
                    unsigned char* h8 = (unsigned char*)H + (size_t)row * D;
                    row_store_fp8_wt(h8, F.lane, v, Q_SA);
                } else {
                    const float rs = row_rstd(v);
#pragma unroll
                    for (int j = 0; j < 4; ++j) st16_wt((f32x4*)(outp + (size_t)row * D) + F.lane + 64 * j, __builtin_bit_cast(u32x4, (v[j] * rs) * pa[j]));
                }
            }
        }
    }
}

__device__ __forceinline__ void p14_conv(ArgP a, const Ctx& F) {
    const bf16* GLU = (const bf16*)(a->ws + WS_GLU); bf16* H = (bf16*)(a->ws + WS_H);
    LAS float* CV = (LAS float*)F.lds;
    const int c0 = 2 * F.tid;
    float w0[31], w1[31];
#pragma unroll
    for (int j = 0; j < 31; ++j) { const f32x2 w = *(const f32x2*)(a->in[I_DWW] + j * 1024 + c0); w0[j] = w.x; w1[j] = w.y; }
    const f32x2 db = *(const f32x2*)(a->in[I_DWB] + c0);
    f32x4 lng[4], lnb[4];
#pragma unroll
    for (int j = 0; j < 4; ++j) { lng[j] = ((const f32x4*)a->in[I_CLNG])[F.lane + 64 * j]; lnb[j] = ((const f32x4*)a->in[I_CLNB])[F.lane + 64 * j]; }
    for (int itr = F.vcu; itr < (NTOK / 32) * PROBE_R_CONV; itr += F.G) { const int it = itr & (NTOK / 32 - 1);
        const int b = it >> 6, t0 = (it & 63) * 32;
        const bf16* base = GLU + (size_t)b * T * D + c0;
        float wa[31], wb[31];
        unsigned nxt[32];
        {   unsigned raw[30];
#pragma unroll
            for (int j = 0; j < 30; ++j) { const int t = t0 - 15 + j; raw[j] = (t >= 0 && t < T) ? *(const unsigned*)(base + (size_t)t * D) : 0u; }
#pragma unroll
            for (int j = 0; j < 32; ++j) { const int t = t0 + j + 15; nxt[j] = (t < T) ? *(const unsigned*)(base + (size_t)t * D) : 0u; }
#pragma unroll
            for (int j = 0; j < 30; ++j) { wa[j + 1] = bflo(raw[j]); wb[j + 1] = bfhi(raw[j]); } }
#pragma unroll
        for (int tl = 0; tl < 32; ++tl) {
#pragma unroll
            for (int j = 0; j < 30; ++j) { wa[j] = wa[j + 1]; wb[j] = wb[j + 1]; }
            wa[30] = bflo(nxt[tl]); wb[30] = bfhi(nxt[tl]);
            float s0 = db.x, s1 = db.y;
#pragma unroll
            for (int j = 0; j < 31; ++j) { s0 += wa[j] * w0[j]; s1 += wb[j] * w1[j]; }
            *(LAS f32x2*)(CV + tl * 1024 + c0) = (f32x2){s0, s1};
            if ((tl & 3) == 3) __builtin_amdgcn_sched_barrier(0);
        }
        __syncthreads();
#pragma unroll 1
        for (int q = 0; q < 4; ++q) {
            const int tl = F.wave * 4 + q; f32x4 v[4];
#pragma unroll
            for (int j = 0; j < 4; ++j) v[j] = ((const LAS f32x4*)(CV + tl * 1024))[F.lane + 64 * j];
            float s = 0.f;
#pragma unroll
            for (int j = 0; j < 4; ++j) s += (v[j].x + v[j].y) + (v[j].z + v[j].w);
            const float mu = wave_sum(s) * (1.0f / D); float sq = 0.f;
#pragma unroll
            for (int j = 0; j < 4; ++j) { v[j] -= mu; sq += (v[j].x * v[j].x + v[j].y * v[j].y) + (v[j].z * v[j].z + v[j].w * v[j].w); }
            const float rs = __frsqrt_rn(wave_sum(sq) * (1.0f / D) + 1e-5f);
#pragma unroll
            for (int j = 0; j < 4; ++j) { const f32x4 gg = lng[j], bb = lnb[j];
                f32x4 y = v[j] * rs * gg + bb; y.x *= sigmoidf_(y.x); y.y *= sigmoidf_(y.y); y.z *= sigmoidf_(y.z); y.w *= sigmoidf_(y.w); v[j] = y; }
            unsigned char* h8 = (unsigned char*)H + (size_t)(b * T + t0 + tl) * D;
            row_store_fp8_wt(h8, F.lane, v, Q_SA);
        }
        __syncthreads();
    }
}

#ifndef MK_ONE_LAUNCH
#define MK_ONE_LAUNCH 1
#endif
constexpr int NPHASE = 21;
constexpr size_t TSTEP = (size_t)256 * 1024 * 2;

__global__ void __launch_bounds__(NTHR, 2) fwd(Args a_unused) {
    extern __shared__ __attribute__((aligned(16))) unsigned char lds_raw[];
    Ctx F; F.lds = (LAS unsigned char*)lds_raw; F.tid = threadIdx.x; F.lane = F.tid & 63; F.wave = __builtin_amdgcn_readfirstlane(F.tid >> 6);
    F.G = gridDim.x; { const int bx = blockIdx.x; F.vcu = (F.G % 8 == 0) ? (bx % 8) * (F.G / 8) + bx / 8 : bx; }
    ArgP a = (ArgP)__builtin_amdgcn_kernarg_segment_ptr();
    unsigned char* ws = a->ws;
    if (F.tid < 64) ((LAS unsigned*)(F.lds + LDSCTL_OFF))[F.tid] = 0u;
    __syncthreads();
    XcdBarrier bar; bar.bar = (unsigned*)(ws + WS_CTL) + CW_BAR; bar.x = 0; bar.st = nullptr;
    if (MK_ONE_LAUNCH) bar = xcd_barrier_post((unsigned*)(ws + WS_CTL) + CW_BAR, (volatile LAS unsigned*)(F.lds + LDSCTL_OFF), F.tid == 0);
    const int lo = a->ph_lo, hi = a->ph_hi;
#ifndef PH_MASK
#define PH_MASK 0xffffffffu
#endif
#define IN(k) ((((PH_MASK) >> ((k) >= 16 ? (k) - 8 : (k))) & 1u) && lo <= (k) && (k) < hi)
#ifdef PROBE_SEAM2
#define SEAM(k) do { if (IN((k) + 1) || ((k) == 2 && IN(4))) { xcd_barrier(bar, F.wave == 0 && lane_id() == 0); xcd_barrier(bar, F.wave == 0 && lane_id() == 0); xcd_barrier(bar, F.wave == 0 && lane_id() == 0); } } while (0)
#else
#define SEAM(k) do { if (IN((k) + 1) || ((k) == 2 && IN(4))) xcd_barrier(bar, F.wave == 0 && lane_id() == 0); } while (0)
#endif
#define FRESH() do { F.tid = F.wave * 64 + lane_id(); asm volatile("" : "+v"(F.tid)); F.lane = F.tid & 63; a = (ArgP)__builtin_amdgcn_kernarg_segment_ptr(); asm volatile("" : "+s"(a)); ws = a->ws; } while (0)
#define MODP ((const float*)(ws + WS_MOD))
#define Hb ((bf16*)(ws + WS_H))
#define TILE_E ((const int*)(ws + RT_TILEE))
#define SLOT_TOK ((const int*)(ws + RT_STOK))

    if (IN(0)) { FRESH(); p0_prologue(a, F); SEAM(0); }
    if (IN(1)) { FRESH(); p1_adaln0(a, F); SEAM(1); }
    if (IN(2)) {
        FRESH();
        pg8::OrderPlain S; S.init(MROWS / 256, NIN / 256, F.G, (int)blockIdx.x); S.A = (const char*)Hb; S.Bt = (const char*)(ws + WS_WIN); S.tstep = TSTEP / 2; S.reps = PROBE_R_DENSE;
        EpiInproj E{(bf16*)(ws + WS_P), (bf16*)(ws + WS_VT), (bf16*)(ws + WS_KB), F.lds};
        pg8::gemm_phase<EpiInproj, pg8::OrderPlain, false, true>(F.lds, 512, S, E, F.tid);
        SEAM(2);
    }
    if (IN(5)) { FRESH(); p5_natten(a, F); }
    if (IN(4)) { FRESH(); p4_scan(a, F); SEAM(5); }
    if (IN(6)) { FRESH(); p6_post(a, F); SEAM(6); }
    if (IN(7)) {
        FRESH();
        pg8::OrderPlain S; S.init(NTOK / 256, 4, F.G, (int)blockIdx.x); S.A = (const char*)Hb; S.Bt = (const char*)(ws + WS_WOUT); S.tstep = TSTEP / 2; S.reps = PROBE_R_DENSE2;
        EpiResid<false> E{a->in[I_X], (bf16*)(ws + WS_X1), MODP + 2048, nullptr};
        pg8::gemm_phase<EpiResid<false>, pg8::OrderPlain, false, true>(F.lds, 512, S, E, F.tid);
        SEAM(7);
    }
#pragma unroll 1
    for (int l = 0; l < 2; ++l) {
        const int pb = l == 0 ? 8 : 16;
        if (IN(pb)) { FRESH(); p8_router(a, F, l); SEAM(pb); }
        if (IN(pb + 1)) { FRESH(); p9_slots(a, F); SEAM(pb + 1); }
        if (IN(pb + 2)) {
        FRESH();
            pg8::OrderMoe S; S.init(TILE_E[1023], 8, F.G, (int)blockIdx.x); S.A = (const char*)Hb; S.Bt = (const char*)(ws + WS_EW1) + (size_t)l * 32 * 2048 * 1024; S.tstep = TSTEP / 2;
            S.estride = (size_t)2048 * 1024; S.tile_e = TILE_E; S.slot_tok = SLOT_TOK; S.reps = PROBE_R_MOEG;
            EpiPair<0> E{(bf16*)(ws + WS_ACT), a->in[I_EB1] + (size_t)l * 32 * 2048, TILE_E};
            pg8::gemm_phase<EpiPair<0>, pg8::OrderMoe, true, true>(F.lds, 512, S, E, F.tid);
        SEAM(pb + 2);
        }
        if (IN(pb + 3)) {
        FRESH();
            pg8::OrderMoe S; S.init(TILE_E[1023], 4, F.G, (int)blockIdx.x); S.A = (const char*)(ws + WS_ACT); S.Bt = (const char*)(ws + WS_EW2) + (size_t)l * 32 * 1024 * 1024; S.tstep = TSTEP / 2;
            S.estride = (size_t)1024 * 1024; S.tile_e = TILE_E; S.slot_tok = SLOT_TOK; S.reps = PROBE_R_MOEG;
            EpiMoe2 E{(bf16*)(ws + WS_YB), a->in[I_EB2] + (size_t)l * 32 * 1024, TILE_E};
            pg8::gemm_phase<EpiMoe2, pg8::OrderMoe, false, true>(F.lds, 512, S, E, F.tid);
        SEAM(pb + 3);
        }
        if (IN(pb + 4)) { FRESH(); p12_combine(a, F, l); SEAM(pb + 4); }
        if (l == 0) {
            if (IN(13)) {
        FRESH();
                pg8::OrderPlain S; S.init(NTOK / 256, 8, F.G, (int)blockIdx.x); S.A = (const char*)Hb; S.Bt = (const char*)(ws + WS_PW1); S.tstep = TSTEP / 2; S.reps = PROBE_R_DENSE2;
                EpiPair<1> E{(bf16*)(ws + WS_GLU), a->in[I_PW1B], nullptr};
                pg8::gemm_phase<EpiPair<1>, pg8::OrderPlain, false, true>(F.lds, 512, S, E, F.tid);
        SEAM(13);
            }
            if (IN(14)) { FRESH(); p14_conv(a, F); SEAM(14); }
            if (IN(15)) {
        FRESH();
                pg8::OrderPlain S; S.init(NTOK / 256, 4, F.G, (int)blockIdx.x); S.A = (const char*)Hb; S.Bt = (const char*)(ws + WS_PW2); S.tstep = TSTEP / 2;
                EpiResid<true> E{(const void*)(ws + WS_X1), (bf16*)(ws + WS_X1), MODP + 16 * 6144 + 2048, a->in[I_PW2B]};
                pg8::gemm_phase<EpiResid<true>, pg8::OrderPlain, false, true>(F.lds, 512, S, E, F.tid);
        SEAM(15);
            }
        }
    }
#undef IN
#undef SEAM
}

extern "C" void kernel_launch(void* const* d_in, const int* in_sizes, int n_in, void* d_out, int out_size, void* d_ws, size_t ws_size, hipStream_t stream) {
    static int grid = 0;
    if (grid == 0) {
        if (n_in != 38 || out_size != NTOK * D || ws_size < WS_END) { fprintf(stderr, "kernel_launch: unexpected problem (n_in %d, out %d, ws %zu < %zu)\n", n_in, out_size, ws_size, (size_t)WS_END); grid = -1; return; }
        int dev = 0, cus = 0, per_cu = 0;
        if (hipGetDevice(&dev) != hipSuccess || hipDeviceGetAttribute(&cus, hipDeviceAttributeMultiprocessorCount, dev) != hipSuccess) { grid = -1; return; }
        if (hipFuncSetAttribute((const void*)fwd, hipFuncAttributeMaxDynamicSharedMemorySize, LDS_BYTES) != hipSuccess) { fprintf(stderr, "kernel_launch: hipFuncSetAttribute failed\n"); grid = -1; return; }
        if (hipOccupancyMaxActiveBlocksPerMultiprocessor(&per_cu, (const void*)fwd, NTHR, LDS_BYTES) != hipSuccess || per_cu < 1)
            fprintf(stderr, "kernel_launch: note: occupancy query reports %d workgroups per CU\n", per_cu);
        (void)hipGetLastError();
        grid = cus;
    }
    if (grid < 0) return;
    if (hipMemsetAsync((char*)d_ws + WS_CTL, 0, CTL_ZERO_BYTES, stream) != hipSuccess) return;
    Args a{};
    for (int i = 0; i < 38; ++i) a.in[i] = (const float*)d_in[i];
    a.out = (float*)d_out; a.ws = (unsigned char*)d_ws;
#if MK_ONE_LAUNCH
    a.ph_lo = 0; a.ph_hi = NPHASE;
    hipLaunchKernelGGL(fwd, dim3(grid), dim3(NTHR), LDS_BYTES, stream, a);
#else
    for (int p = 0; p < NPHASE; ++p) { a.ph_lo = p; a.ph_hi = p + 1; hipLaunchKernelGGL(fwd, dim3(grid), dim3(NTHR), LDS_BYTES, stream, a); }
#endif
}
```
